# Optimizing an MI355X kernel written in HIP

```python
import math
import jax, jax.numpy as jnp
from jax import lax
import numpy as np

D_MODEL = 2048
BATCH = 4
SEQ = 2048
DEPTH = 1
DEC_BATCH = 128
DEC_SEQ = 4
PAST_LEN = 16384
PAGE_SIZE = 128

N_MEM = 256
C_CONV = 1024
CONV_WIDTH = 31
DN_HEADS = 8
DN_DK = 128
DN_DV = 128
DN_CONV = 4
DN_CHUNK = 64
XA_HEADS = 4
XA_DIM = 256
QKV_W = DN_HEADS * (2 * DN_DK + DN_DV)
D_FF = -(-(8 * D_MODEL) // (3 * 256)) * 256
IN_SIZES = (2 * C_CONV, QKV_W, DN_HEADS * DN_DV, DN_HEADS, DN_HEADS, XA_HEADS * XA_DIM, 3 * D_MODEL)
IN_TOTAL = sum(IN_SIZES)
IN_SPLITS = tuple(sum(IN_SIZES[:i + 1]) for i in range(len(IN_SIZES) - 1))

kernel_name = 'hybrid_conformer_gdn_memxattn_decode_step'


def rmsnorm(x, g, eps=1e-6):
    xf = x.astype(jnp.float32)
    y = xf * lax.rsqrt(jnp.mean(xf * xf, axis=-1, keepdims=True) + eps)
    return (y * g.astype(jnp.float32)).astype(x.dtype)


def layernorm(x, g, b, eps=1e-5):
    xf = x.astype(jnp.float32)
    mu = jnp.mean(xf, axis=-1, keepdims=True)
    xc = xf - mu
    y = xc * lax.rsqrt(jnp.mean(xc * xc, axis=-1, keepdims=True) + eps)
    return (y * g.astype(jnp.float32) + b.astype(jnp.float32)).astype(x.dtype)


def l2norm(x, eps=1e-6):
    return x * lax.rsqrt(jnp.sum(x * x, axis=-1, keepdims=True) + eps)


def causal_depthwise(x_ext, w):
    c = x_ext.shape[-1]
    return lax.conv_general_dilated(x_ext, w[:, None, :].astype(x_ext.dtype), window_strides=(1,),
                                    padding='VALID', dimension_numbers=('NWC', 'WIO', 'NWC'),
                                    feature_group_count=c)


def gated_delta_chunked(q, k, v, g, beta, s0):
    B, T, H, DK = q.shape
    DV = v.shape[-1]
    C = min(DN_CHUNK, T)
    n = -(-T // C)
    pad = n * C - T

    def prep(a):
        a = jnp.pad(a, [(0, 0), (0, pad)] + [(0, 0)] * (a.ndim - 2))
        a = a.reshape((B, n, C) + a.shape[2:])
        return jnp.moveaxis(a, 3, 1)

    q, k, v, g, beta = (prep(a) for a in (q, k, v, g, beta))
    gam = jnp.cumsum(g, axis=-1)
    diff = gam[..., :, None] - gam[..., None, :]
    causal = jnp.tril(jnp.ones((C, C), dtype=bool))
    strict = jnp.tril(jnp.ones((C, C), dtype=bool), -1)
    decay_incl = jnp.exp(jnp.where(causal, diff, -jnp.inf))
    decay_strict = jnp.where(strict, decay_incl, 0.0)
    kb = k * beta[..., None]
    a_mat = jnp.einsum('bhncd,bhnsd->bhncs', kb, k) * decay_strict + jnp.eye(C, dtype=jnp.float32)
    rhs = jnp.concatenate([v * beta[..., None], kb * jnp.exp(gam)[..., None]], axis=-1)
    sol = lax.linalg.triangular_solve(a_mat, rhs, left_side=True, lower=True)
    u, kcum = sol[..., :DV], sol[..., DV:]
    qk = jnp.einsum('bhncd,bhnsd->bhncs', q, k) * decay_incl
    qg = q * jnp.exp(gam)[..., None]
    kg = k * jnp.exp(gam[..., -1:] - gam)[..., None]
    g_last = jnp.exp(gam[..., -1])
    xs = tuple(jnp.moveaxis(a, 2, 0) for a in (qg, kg, u, kcum, qk, g_last))

    def step(s, inp):
        qg_i, kg_i, u_i, kc_i, qk_i, gl_i = inp
        w = u_i - jnp.einsum('bhcd,bhde->bhce', kc_i, s)
        o = jnp.einsum('bhcd,bhde->bhce', qg_i, s) + jnp.einsum('bhcs,bhse->bhce', qk_i, w)
        s = s * gl_i[..., None, None] + jnp.einsum('bhcd,bhce->bhde', kg_i, w)
        return s, o

    s_fin, o = lax.scan(step, s0, xs)
    o = jnp.transpose(o, (1, 0, 3, 2, 4)).reshape(B, n * C, H, DV)[:, :T]
    return o, s_fin


def memory_kv(mem, g_mem, w_mem_kv):
    B = mem.shape[0]
    m = rmsnorm(mem, g_mem) @ w_mem_kv
    mk, mv = jnp.split(m, 2, axis=-1)
    return (mk.reshape(B, N_MEM, XA_HEADS, XA_DIM), mv.reshape(B, N_MEM, XA_HEADS, XA_DIM))


def decoder_layer(x, mem_k, mem_v, conv_buf, dconv_buf, s0, lw):
    B, T, _ = x.shape
    dt = x.dtype
    f32 = jnp.float32
    u = rmsnorm(x, lw['g_pre_mix'])
    proj = u @ lw['w_in']
    glu, qkv, z, b_raw, a_raw, xq, gates = jnp.split(proj, IN_SPLITS, axis=-1)

    ga, gb = jnp.split(glu, 2, axis=-1)
    c_ext = jnp.concatenate([conv_buf.astype(dt), ga * jax.nn.sigmoid(gb)], axis=1)
    c = causal_depthwise(c_ext, lw['w_dw']) + lw['b_dw']
    c = jax.nn.silu(layernorm(c, lw['ln_g'], lw['ln_b']))
    br_conv = c @ lw['w_p_conv'] + lw['b_p_conv']
    new_conv_buf = c_ext[:, -(CONV_WIDTH - 1):]

    d_ext = jnp.concatenate([dconv_buf.astype(dt), qkv], axis=1)
    qkv_c = jax.nn.silu(causal_depthwise(d_ext, lw['w_dconv'])).astype(f32)
    new_dconv_buf = d_ext[:, -(DN_CONV - 1):]
    q, k, v = jnp.split(qkv_c, [DN_HEADS * DN_DK, 2 * DN_HEADS * DN_DK], axis=-1)
    q = l2norm(q.reshape(B, T, DN_HEADS, DN_DK)) * (DN_DK ** -0.5)
    k = l2norm(k.reshape(B, T, DN_HEADS, DN_DK))
    v = v.reshape(B, T, DN_HEADS, DN_DV)
    beta = jax.nn.sigmoid(b_raw.astype(f32))
    g = -jnp.exp(lw['a_log'].astype(f32)) * jax.nn.softplus(a_raw.astype(f32) + lw['dt_bias'].astype(f32))
    o, s_new = gated_delta_chunked(q, k, v, g, beta, s0.astype(f32))
    o = rmsnorm(o, lw['g_dn_norm']) * jax.nn.silu(z.astype(f32).reshape(B, T, DN_HEADS, DN_DV))
    br_delta = o.reshape(B, T, DN_HEADS * DN_DV).astype(dt) @ lw['w_p_delta']

    xq = xq.reshape(B, T, XA_HEADS, XA_DIM)
    sc = jnp.einsum('bthd,bmhd->bhtm', xq, mem_k.astype(dt)).astype(f32) * (XA_DIM ** -0.5)
    pr = jax.nn.softmax(sc, axis=-1).astype(dt)
    xo = jnp.einsum('bhtm,bmhd->bthd', pr, mem_v.astype(dt)).reshape(B, T, XA_HEADS * XA_DIM)
    br_mem = xo @ lw['w_p_mem']

    gc, gd, gx = jnp.split(jax.nn.sigmoid(gates.astype(f32)).astype(dt), 3, axis=-1)
    mix = (gc * br_conv + gd * br_delta + gx * br_mem) @ lw['w_o']
    h = x + rmsnorm(mix, lw['g_post_mix'])

    f = rmsnorm(h, lw['g_pre_ffn'])
    f = (jax.nn.silu(f @ lw['w_gate']) * (f @ lw['w_up'])) @ lw['w_down']
    y = h + rmsnorm(f, lw['g_post_ffn'])
    return y, new_conv_buf, new_dconv_buf, s_new


def setup_inputs(seed: int = 0) -> dict:
    key = jax.random.key(seed)
    ks = iter(list(jax.random.split(key, 48)))
    f32 = jnp.float32

    def nrm(shape, scale):
        return scale * jax.random.normal(next(ks), shape, f32)

    def gain(shape):
        return 1.0 + nrm(shape, 0.02)

    L = DEPTH
    XW = XA_HEADS * XA_DIM
    inp = {}
    inp['x_prompt'] = nrm((BATCH, SEQ, D_MODEL), 1.0)
    inp['x_sample'] = nrm((DEC_BATCH, DEC_SEQ, D_MODEL), 1.0)
    inp['mem_prompt'] = nrm((BATCH, N_MEM, D_MODEL), 1.0)
    inp['cache_mem_k'] = nrm((L, DEC_BATCH, N_MEM, XA_HEADS, XA_DIM), 1.0)
    inp['cache_mem_v'] = nrm((L, DEC_BATCH, N_MEM, XA_HEADS, XA_DIM), 1.0)
    inp['state_conv'] = nrm((L, DEC_BATCH, CONV_WIDTH - 1, C_CONV), 0.5)
    inp['state_delta_conv'] = nrm((L, DEC_BATCH, DN_CONV - 1, QKV_W), 1.0)
    inp['state_delta'] = nrm((L, DEC_BATCH, DN_HEADS, DN_DK, DN_DV), 0.05)
    inp['g_pre_mix'] = gain((L, D_MODEL))
    inp['w_in'] = nrm((L, D_MODEL, IN_TOTAL), D_MODEL ** -0.5)
    inp['w_dw'] = nrm((L, CONV_WIDTH, C_CONV), CONV_WIDTH ** -0.5)
    inp['b_dw'] = nrm((L, C_CONV), 0.02)
    inp['ln_g'] = gain((L, C_CONV))
    inp['ln_b'] = nrm((L, C_CONV), 0.02)
    inp['w_p_conv'] = nrm((L, C_CONV, D_MODEL), C_CONV ** -0.5)
    inp['b_p_conv'] = nrm((L, D_MODEL), 0.02)
    inp['w_dconv'] = nrm((L, DN_CONV, QKV_W), DN_CONV ** -0.5)
    inp['a_log'] = jnp.log(jax.random.uniform(next(ks), (L, DN_HEADS), f32, 1.0, 16.0))
    dtv = jnp.exp(jax.random.uniform(next(ks), (L, DN_HEADS), f32, math.log(1e-3), math.log(1e-1)))
    inp['dt_bias'] = dtv + jnp.log(-jnp.expm1(-dtv))
    inp['g_dn_norm'] = gain((L, DN_DV))
    inp['w_p_delta'] = nrm((L, DN_HEADS * DN_DV, D_MODEL), (DN_HEADS * DN_DV) ** -0.5)
    inp['g_mem'] = gain((L, D_MODEL))
    inp['w_mem_kv'] = nrm((L, D_MODEL, 2 * XW), D_MODEL ** -0.5)
    inp['w_p_mem'] = nrm((L, XW, D_MODEL), XW ** -0.5)
    inp['w_o'] = nrm((L, D_MODEL, D_MODEL), D_MODEL ** -0.5)
    inp['g_post_mix'] = gain((L, D_MODEL))
    inp['g_pre_ffn'] = gain((L, D_MODEL))
    inp['w_gate'] = nrm((L, D_MODEL, D_FF), D_MODEL ** -0.5)
    inp['w_up'] = nrm((L, D_MODEL, D_FF), D_MODEL ** -0.5)
    inp['w_down'] = nrm((L, D_FF, D_MODEL), D_FF ** -0.5)
    inp['g_post_ffn'] = gain((L, D_MODEL))
    return inp


def reference(x_prompt, x_sample, mem_prompt, cache_mem_k, cache_mem_v, state_conv, state_delta_conv,
              state_delta, g_pre_mix, w_in, w_dw, b_dw, ln_g, ln_b, w_p_conv, b_p_conv, w_dconv, a_log,
              dt_bias, g_dn_norm, w_p_delta, g_mem, w_mem_kv, w_p_mem, w_o, g_post_mix, g_pre_ffn, w_gate,
              w_up, w_down, g_post_ffn):
    B = x_prompt.shape[0]
    hp, hs = x_prompt, x_sample
    mk_l, mv_l, pc_l, pd_l, ps_l, sc_l, sd_l, ss_l = [], [], [], [], [], [], [], []
    for l in range(DEPTH):
        lw = dict(g_pre_mix=g_pre_mix[l], w_in=w_in[l], w_dw=w_dw[l], b_dw=b_dw[l], ln_g=ln_g[l],
                  ln_b=ln_b[l], w_p_conv=w_p_conv[l], b_p_conv=b_p_conv[l], w_dconv=w_dconv[l],
                  a_log=a_log[l], dt_bias=dt_bias[l], g_dn_norm=g_dn_norm[l], w_p_delta=w_p_delta[l],
                  w_p_mem=w_p_mem[l], w_o=w_o[l], g_post_mix=g_post_mix[l], g_pre_ffn=g_pre_ffn[l],
                  w_gate=w_gate[l], w_up=w_up[l], w_down=w_down[l], g_post_ffn=g_post_ffn[l])
        mk, mv = memory_kv(mem_prompt, g_mem[l], w_mem_kv[l])
        zc = jnp.zeros((B, CONV_WIDTH - 1, C_CONV), hp.dtype)
        zd = jnp.zeros((B, DN_CONV - 1, QKV_W), hp.dtype)
        zs = jnp.zeros((B, DN_HEADS, DN_DK, DN_DV), jnp.float32)
        hp, pc, pd, ps = decoder_layer(hp, mk, mv, zc, zd, zs, lw)
        hs, sc, sd, ss = decoder_layer(hs, cache_mem_k[l], cache_mem_v[l], state_conv[l],
                                       state_delta_conv[l], state_delta[l], lw)
        mk_l.append(mk); mv_l.append(mv); pc_l.append(pc); pd_l.append(pd); ps_l.append(ps)
        sc_l.append(sc); sd_l.append(sd); ss_l.append(ss)
    return (hp, hs, jnp.stack(mk_l), jnp.stack(mv_l), jnp.stack(pc_l), jnp.stack(pd_l), jnp.stack(ps_l),
            jnp.stack(sc_l), jnp.stack(sd_l), jnp.stack(ss_l))
```

```cpp
#include <hip/hip_runtime.h>
#include <hip/hip_cooperative_groups.h>
#include <cstdio>
#include <cstdint>
namespace cg = cooperative_groups;

#define LAS __attribute__((address_space(3)))
typedef unsigned short bf16_t;
typedef short bf16x8 __attribute__((ext_vector_type(8)));
typedef float f32x4 __attribute__((ext_vector_type(4)));
typedef float f32x2 __attribute__((ext_vector_type(2)));
typedef unsigned u32x4 __attribute__((ext_vector_type(4)));
typedef unsigned u32x2 __attribute__((ext_vector_type(2)));

constexpr int DM = 2048, MT = 8704, MP = 8192, PW = 12288;
constexpr int P_GLU = 0, P_Q = 1024, P_Z = 4096, P_XQ = 5120, P_G = 6144;
constexpr int WIN_N = 13328, DFF = 5632;
constexpr size_t O_Y = 0, O_MK = 17825792, O_MV = 18874368, O_CP = 19922944, O_DCP = 20045824, O_DSP = 20082688, O_CS = 20606976, O_DCS = 24539136, O_DSS = 25718784;
constexpr size_t WS_WT_IN = 0;
constexpr size_t WS_WT_BA = WS_WT_IN + (size_t)13312 * 2048 * 2;
constexpr size_t WS_WT_PC = WS_WT_BA + 65536;
constexpr size_t WS_WT_PD = WS_WT_PC + 4194304;
constexpr size_t WS_WT_PM = WS_WT_PD + 4194304;
constexpr size_t WS_WT_O = WS_WT_PM + 4194304;
constexpr size_t WS_WT_MKV = WS_WT_O + 8388608;
constexpr size_t WS_WT_GU = WS_WT_MKV + 8388608;
constexpr size_t WS_WT_DN = WS_WT_GU + (size_t)11264 * 2048 * 2;
constexpr size_t WS_U = WS_WT_DN + (size_t)2048 * 5632 * 2;
constexpr size_t WS_MEMN = WS_U + (size_t)MT * 2048 * 2;
constexpr size_t WS_PROJ = WS_MEMN + 4194304;
constexpr size_t WS_BA = WS_PROJ + (size_t)MT * PW * 2;
constexpr size_t WS_MKB = WS_BA + (size_t)MT * 16 * 4;
constexpr size_t WS_MVB = WS_MKB + 2097152;
constexpr size_t WS_MVT = WS_MVB + 2097152;
constexpr size_t WS_CB = WS_MVT + 2097152;
constexpr size_t WS_OD = WS_CB + (size_t)MT * 1024 * 2;
constexpr size_t WS_XO = WS_OD + (size_t)MT * 1024 * 2;
constexpr size_t WS_D2 = WS_XO + (size_t)MT * 1024 * 2;
constexpr size_t D2_BYTES = 90112;
constexpr size_t WS_GL = WS_D2 + (size_t)1024 * D2_BYTES;
constexpr size_t WS_BAR = WS_GL + 4096;
constexpr size_t WS_SL = WS_BAR + 16384;
constexpr size_t SLAB_ELEMS = (size_t)512 * 2048;
constexpr size_t WS_SW = WS_SL + 12 * SLAB_ELEMS * 4;
constexpr size_t WS_END = WS_SW + (size_t)1024 * 8 * 6144;
constexpr size_t WS_MS = WS_SL;
constexpr size_t MS_ELEMS = (size_t)1024 * 2048;
static_assert(WS_MS + 8 * MS_ELEMS * 4 <= WS_END, "mem_kv slabs must fit the SL | SW regions");
constexpr int LDS_BYTES = 147456;

struct Params { const float* in[31]; float* out; unsigned char* ws; int ph_lo, ph_hi, dup, pad; };
typedef const __attribute__((address_space(4))) Params* KP;
__device__ __forceinline__ KP kparams() { KP k = (KP)__builtin_amdgcn_kernarg_segment_ptr(); asm volatile("" : "+s"(k)); return k; }

typedef __bf16 v2bf_t __attribute__((ext_vector_type(2)));
__device__ __forceinline__ unsigned cvt_pk_bf16(float lo, float hi) { const f32x2 f = {lo, hi}; const v2bf_t r = __builtin_convertvector(f, v2bf_t); return __builtin_bit_cast(unsigned, r); }
__device__ __forceinline__ float bflo(unsigned w) { return __uint_as_float(w << 16); }
__device__ __forceinline__ float bfhi(unsigned w) { return __uint_as_float(w & 0xffff0000u); }
__device__ __forceinline__ float bf2f(bf16_t b) { return __uint_as_float(((unsigned)b) << 16); }
__device__ __forceinline__ bf16_t f2bf(float f) { return (bf16_t)(cvt_pk_bf16(f, 0.f) & 0xffffu); }
__device__ __forceinline__ float sigmoidf_(float x) { return __builtin_amdgcn_rcpf(1.f + __expf(-x)); }
__device__ __forceinline__ float siluf_(float x) { return x * sigmoidf_(x); }
__device__ __forceinline__ float wave_sum(float v) {
#pragma unroll
    for (int o = 1; o < 64; o <<= 1) v += __shfl_xor(v, o);
    return v;
}
__device__ __forceinline__ float wave_max(float v) {
#pragma unroll
    for (int o = 1; o < 64; o <<= 1) v = fmaxf(v, __shfl_xor(v, o));
    return v;
}
__device__ __forceinline__ bf16x8 pack8(f32x4 a, f32x4 b) {
    u32x4 w; w.x = cvt_pk_bf16(a[0], a[1]); w.y = cvt_pk_bf16(a[2], a[3]); w.z = cvt_pk_bf16(b[0], b[1]); w.w = cvt_pk_bf16(b[2], b[3]);
    return __builtin_bit_cast(bf16x8, w);
}
__device__ __forceinline__ int ltid() { int t = threadIdx.x; asm volatile("" : "+v"(t)); return t; }
#define LDS_WAIT() asm volatile("s_waitcnt lgkmcnt(0)" ::: "memory")
#define MFMA16(a, b, c) __builtin_amdgcn_mfma_f32_16x16x32_bf16((a), (b), (c), 0, 0, 0)
__device__ __forceinline__ int perm_off(int p) { return 16 * ((p & 7) >> 2) + 4 * (p >> 3) + (p & 3); }
__device__ __forceinline__ int perm_pos(int o) { return (((o >> 2) & 3) << 3) | ((o >> 4) << 2) | (o & 3); }

namespace pg8 {
#define PG8_LAS __attribute__((address_space(3)))
constexpr int BM = 256, BK = 64, HALF = 128, HTB = HALF * BK * 2, STAGE_BYTES = 8 * HTB, NXCD = 8, WGM = 8;
__host__ __device__ __forceinline__ int lds_byte(int r, int c) { const int st = (r >> 4) * 2 + (c >> 5), rr = r & 15, cc = c & 31, ob = rr * 64 + cc * 2; return st * 1024 + (ob ^ (((ob >> 9) & 1) << 5)); }
__host__ __device__ __forceinline__ void stage_rc(int b, int& R, int& C) { const int st = b / 1024, sb = b % 1024, swz = sb ^ (((sb >> 9) & 1) << 5); R = (st >> 1) * 16 + swz / 64; C = (st & 1) * 32 + (swz % 64) / 2; }
__host__ __device__ __forceinline__ int perm32(int rho) { const int n = rho >> 4, i = rho & 15; return 8 * (i >> 2) + 4 * n + (i & 3); }
struct Unit { int pm, pn, br, ks; };
__device__ __forceinline__ void map_unit(int L, int nM, int nN, int& pm, int& pn) {
    const int nwg = nM * nN; int wgid = L;
    { const int q = nwg / NXCD, r = nwg % NXCD, xcd = wgid % NXCD, off = wgid / NXCD; wgid = (xcd < r ? xcd * (q + 1) : r * (q + 1) + (xcd - r) * q) + off; }
    const int nig = WGM * nN, gid = wgid / nig, fm = gid * WGM, gsz = (nM - fm) < WGM ? (nM - fm) : WGM;
    pm = fm + ((wgid % nig) % gsz); pn = (wgid % nig) / gsz;
}
template <class Epi, class Sched, bool ALIGN_EPI = false, bool SP2 = false>
__device__ __forceinline__ void gemm_phase(PG8_LAS unsigned char* lds, const int K_, const Sched& S, const Epi& E) {
    const int tid = ltid(), wid = __builtin_amdgcn_readfirstlane(tid >> 6), lane = tid & 63, wr = wid >> 2, wc = wid & 3, fr = lane & 15, fq = lane >> 4;
    const int K = K_; int nt = K / BK;
    unsigned voffA[2], voffB[2];
#pragma unroll
    for (int i = 0; i < 2; ++i) { int R, C; stage_rc(tid * 16 + i * 8192, R, C); const int Rb = Epi::PERM ? ((R & ~31) + perm32(R & 31)) : R;
        voffA[i] = (unsigned)(R * K + C) * 2u; voffB[i] = (unsigned)(Rb * K + C) * 2u; }
    const size_t kstep = (size_t)(BK * 2);
    const size_t hstep = (size_t)HALF * K * 2;
    const size_t tstep = 2 * hstep;
    const unsigned ldsw = (unsigned)wid * 1024u;
    const int aoff = lds_byte(wr * 64 + fr, fq * 8), boff = lds_byte(wc * 32 + fr, fq * 8);
#define PG8_SA(b, h) (((b) * 2 + (h)) * HTB)
#define PG8_SB(b, h) ((4 + (b) * 2 + (h)) * HTB)
#define PG8_STAGE(bufoff, gbase, voff) do { _Pragma("unroll") for (int _i = 0; _i < 2; ++_i) \
        __builtin_amdgcn_global_load_lds((const unsigned*)((const char*)(gbase) + (voff)[_i]), (PG8_LAS unsigned*)(lds + (bufoff) + ldsw + _i * 8192), 16, 0, 0); } while (0)
#define PG8_LDA(dst, b, h) do { _Pragma("unroll") for (int m = 0; m < 4; ++m) _Pragma("unroll") for (int k = 0; k < 2; ++k) dst[m][k] = *(const PG8_LAS bf16x8*)(lds + PG8_SA(b, h) + aoff + m * 2048 + k * 1024); } while (0)
#define PG8_LDB(dst, b, h) do { _Pragma("unroll") for (int n = 0; n < 2; ++n) _Pragma("unroll") for (int k = 0; k < 2; ++k) dst[n][k] = *(const PG8_LAS bf16x8*)(lds + PG8_SB(b, h) + boff + n * 2048 + k * 1024); } while (0)
#define PG8_MMA(ai, bj, At, Bt) do { __builtin_amdgcn_s_setprio(1); _Pragma("unroll") for (int m = 0; m < 4; ++m) _Pragma("unroll") for (int n = 0; n < 2; ++n) _Pragma("unroll") for (int k = 0; k < 2; ++k) \
        acc[ai][bj][m][n] = __builtin_amdgcn_mfma_f32_16x16x32_bf16(Bt[n][k], At[m][k], acc[ai][bj][m][n], 0, 0, 0); __builtin_amdgcn_s_setprio(0); } while (0)
#define PG8_WAIT_V(n) asm volatile("s_waitcnt vmcnt(" #n ")" ::: "memory")
#define PG8_WAIT_L(n) asm volatile("s_waitcnt lgkmcnt(" #n ")" ::: "memory")
#define PG8_BAR __builtin_amdgcn_s_barrier()
#define PG8_SCHED __builtin_amdgcn_sched_barrier(0)
    Unit cur, nxt; int ui = 0;
    if (!S.next(0, cur)) return;
    nt = S.nkt(cur);
    f32x4 acc[2][2][4][2];
#pragma unroll
    for (int a = 0; a < 2; ++a)
#pragma unroll
        for (int b = 0; b < 2; ++b)
#pragma unroll
            for (int m = 0; m < 4; ++m)
#pragma unroll
                for (int n = 0; n < 2; ++n) acc[a][b][m][n] = (f32x4){0.f, 0.f, 0.f, 0.f};
    bf16x8 At[4][2], B0[2][2], B1[2][2];
    const char* cA = S.aptr(cur); const char* cB = S.bptr(cur);
    S.a_ready(cur);
    if constexpr (SP2) {
        PG8_STAGE(PG8_SB(0, 0), cB, voffB); PG8_STAGE(PG8_SB(0, 1), cB + hstep, voffB); PG8_STAGE(PG8_SA(0, 0), cA, voffA); PG8_STAGE(PG8_SA(0, 1), cA + hstep, voffA);
        if (wr == 1) PG8_BAR;
        PG8_WAIT_V(2); PG8_BAR;
        PG8_STAGE(PG8_SB(1, 0), cB + kstep, voffB); PG8_STAGE(PG8_SA(1, 0), cA + kstep, voffA); PG8_STAGE(PG8_SB(1, 1), cB + hstep + kstep, voffB);
        PG8_WAIT_V(6); PG8_BAR;
    } else {
        PG8_STAGE(PG8_SB(0, 0), cB, voffB); PG8_STAGE(PG8_SA(0, 0), cA, voffA); PG8_STAGE(PG8_SB(0, 1), cB + hstep, voffB); PG8_STAGE(PG8_SA(0, 1), cA + hstep, voffA);
        if (wr == 1) PG8_BAR;
        PG8_WAIT_V(4); PG8_BAR;
        PG8_STAGE(PG8_SB(1, 0), cB + kstep, voffB); PG8_STAGE(PG8_SA(1, 0), cA + kstep, voffA); PG8_STAGE(PG8_SB(1, 1), cB + hstep + kstep, voffB);
        PG8_WAIT_V(6); PG8_BAR;
    }
    for (;;) {
        const bool has_next = S.next(ui + 1, nxt);
        const char* nA = has_next ? S.aptr(nxt) : cA; const char* nB = has_next ? S.bptr(nxt) : cB;
        for (int t = 0; t < nt; t += 2) {
            const bool last = (t == nt - 2);
            const char* a1 = cA + (size_t)(t + 1) * kstep;
            const char* a2 = last ? nA : cA + (size_t)(t + 2) * kstep; const char* b2 = last ? nB : cB + (size_t)(t + 2) * kstep;
            const char* a3 = a2 + kstep; const char* b3 = b2 + kstep;
            if (last && has_next) S.a_ready(nxt);
            if constexpr (SP2) {
            PG8_LDB(B0, 0, 0); PG8_LDB(B1, 0, 1); PG8_SCHED; PG8_LDA(At, 0, 0); PG8_STAGE(PG8_SA(1, 1), a1 + hstep, voffA);
            PG8_WAIT_V(8); PG8_WAIT_L(0); PG8_BAR; PG8_MMA(0, 0, At, B0); PG8_MMA(0, 1, At, B1); PG8_BAR; PG8_SCHED;
            PG8_LDA(At, 0, 1); PG8_STAGE(PG8_SB(0, 0), b2, voffB); PG8_STAGE(PG8_SB(0, 1), b2 + hstep, voffB); PG8_STAGE(PG8_SA(0, 0), a2, voffA);
            PG8_WAIT_V(8); PG8_WAIT_L(0); PG8_BAR; PG8_MMA(1, 0, At, B0); PG8_MMA(1, 1, At, B1); PG8_BAR; PG8_SCHED;
            PG8_LDB(B0, 1, 0); PG8_LDB(B1, 1, 1); PG8_SCHED; PG8_LDA(At, 1, 0); PG8_STAGE(PG8_SA(0, 1), a2 + hstep, voffA);
            PG8_WAIT_V(8); PG8_WAIT_L(0); PG8_BAR; PG8_MMA(0, 0, At, B0); PG8_MMA(0, 1, At, B1); PG8_BAR; PG8_SCHED;
            PG8_LDA(At, 1, 1); PG8_STAGE(PG8_SB(1, 0), b3, voffB); PG8_STAGE(PG8_SB(1, 1), b3 + hstep, voffB); PG8_STAGE(PG8_SA(1, 0), a3, voffA);
            PG8_WAIT_V(8); PG8_WAIT_L(0); PG8_BAR; PG8_MMA(1, 0, At, B0); PG8_MMA(1, 1, At, B1); PG8_BAR; PG8_SCHED;
            } else {
            PG8_LDB(B0, 0, 0); PG8_SCHED; PG8_LDA(At, 0, 0); PG8_STAGE(PG8_SA(1, 1), a1 + hstep, voffA);
            PG8_WAIT_L(8); PG8_BAR; PG8_WAIT_L(0); PG8_MMA(0, 0, At, B0); PG8_BAR; PG8_SCHED;
            PG8_LDB(B1, 0, 1); PG8_STAGE(PG8_SB(0, 0), b2, voffB);
            PG8_BAR; PG8_WAIT_L(0); PG8_MMA(0, 1, At, B1); PG8_BAR;
            PG8_LDA(At, 0, 1); PG8_STAGE(PG8_SA(0, 0), a2, voffA);
            PG8_BAR; PG8_WAIT_L(0); PG8_MMA(1, 0, At, B0); PG8_BAR; PG8_SCHED;
            PG8_STAGE(PG8_SB(0, 1), b2 + hstep, voffB);
            PG8_WAIT_V(6); PG8_BAR; PG8_MMA(1, 1, At, B1); PG8_BAR;
            PG8_LDB(B0, 1, 0); PG8_SCHED; PG8_LDA(At, 1, 0); PG8_STAGE(PG8_SA(0, 1), a2 + hstep, voffA);
            PG8_WAIT_L(8); PG8_BAR; PG8_WAIT_L(0); PG8_MMA(0, 0, At, B0); PG8_BAR; PG8_SCHED;
            PG8_LDB(B1, 1, 1); PG8_STAGE(PG8_SB(1, 0), b3, voffB);
            PG8_BAR; PG8_WAIT_L(0); PG8_MMA(0, 1, At, B1); PG8_BAR;
            PG8_LDA(At, 1, 1); PG8_STAGE(PG8_SA(1, 0), a3, voffA);
            PG8_BAR; PG8_WAIT_L(0); PG8_MMA(1, 0, At, B0); PG8_BAR; PG8_SCHED;
            PG8_STAGE(PG8_SB(1, 1), b3 + hstep, voffB);
            PG8_WAIT_V(6); PG8_BAR; PG8_MMA(1, 1, At, B1); PG8_BAR;
            }
        }
        if constexpr (ALIGN_EPI) { if (wr == 0) PG8_BAR; }
        if constexpr (!Epi::AFTER_DRAIN) { E(acc, cur, wr, wc, fr, fq); S.done(cur); }
        if (!has_next) break;
#pragma unroll
        for (int a = 0; a < 2; ++a)
#pragma unroll
            for (int b = 0; b < 2; ++b)
#pragma unroll
                for (int m = 0; m < 4; ++m)
#pragma unroll
                    for (int n = 0; n < 2; ++n) acc[a][b][m][n] = (f32x4){0.f, 0.f, 0.f, 0.f};
        cur = nxt; cA = nA; cB = nB; ++ui; nt = S.nkt(cur);
        if constexpr (ALIGN_EPI) { if (wr == 1) PG8_BAR; }
    }
    PG8_WAIT_V(0);
    if constexpr (!ALIGN_EPI) { if (wr == 0) PG8_BAR; }
    PG8_BAR;
    if constexpr (Epi::AFTER_DRAIN) { E.fused(acc, cur, wr, wc, fr, fq, lds, wid, lane); S.done(cur); }
#undef PG8_SA
#undef PG8_SB
#undef PG8_STAGE
#undef PG8_LDA
#undef PG8_LDB
#undef PG8_MMA
#undef PG8_WAIT_V
#undef PG8_WAIT_L
#undef PG8_BAR
#undef PG8_SCHED
}
}
using pg8::Unit;

struct SchedG {
    const bf16_t* A; const bf16_t* Bt; int nM, nN, K, G, c;
    __device__ __forceinline__ bool next(int i, Unit& u) const { const long L = (long)i * G + c; if (L >= (long)nM * nN) return false; pg8::map_unit((int)L, nM, nN, u.pm, u.pn); u.br = 0; u.ks = -1; return true; }
    __device__ __forceinline__ const char* aptr(const Unit& u) const { return (const char*)(A + (size_t)u.pm * 256 * K); }
    __device__ __forceinline__ const char* bptr(const Unit& u) const { return (const char*)(Bt + (size_t)u.pn * 256 * K); }
    __device__ __forceinline__ int nkt(const Unit&) const { return K / 64; }
    __device__ __forceinline__ void a_ready(const Unit&) const {}
    __device__ __forceinline__ void done(const Unit&) const {}
};
struct Sched1 {
    const bf16_t *U, *WtIn, *MemN, *WtMkv; int G, c;
    __device__ __forceinline__ bool next(int i, Unit& u) const {
        const int nf = c < 1768 ? (1768 - c + G - 1) / G : 0;
        const int jsub = nf * G + c - 1768;
        const bool hassub = jsub < 256, odd = (c & 1) && hassub;
        const int k = odd ? i - 1 : i;
        const bool issub = odd ? (i == 0) : (i == nf);
        if (issub ? !hassub : (k < 0 || k >= nf)) return false;
        const bool full = !issub; const int j = full ? 0 : jsub;
        int pm_, pn_; pg8::map_unit(full ? k * G + c : 0, 34, 52, pm_, pn_);
        const int t = j >> 3;
        u.pm = full ? pm_ : (t >> 3); u.pn = full ? pn_ : (t & 7); u.br = full ? 0 : 1; u.ks = full ? -1 : (j & 7); return true;
    }
    __device__ __forceinline__ const char* aptr(const Unit& u) const { return (const char*)((u.br ? MemN : U) + (size_t)u.pm * 256 * 2048 + (u.br ? u.ks * 256 : 0)); }
    __device__ __forceinline__ const char* bptr(const Unit& u) const { return (const char*)((u.br ? WtMkv : WtIn) + (size_t)u.pn * 256 * 2048 + (u.br ? u.ks * 256 : 0)); }
    __device__ __forceinline__ int nkt(const Unit& u) const { return u.br ? 4 : 32; }
    __device__ __forceinline__ void a_ready(const Unit&) const {}
    __device__ __forceinline__ void done(const Unit&) const {}
};
struct Sched4 {
    const bf16_t *A0, *B0; int G, c;
    __device__ __forceinline__ bool next(int i, Unit& u) const {
        const int nfull = 3 * ((256 - c + G - 1) / G);
        const bool pr = i < nfull; const int tri = pr ? (i / 3) * G + c : 0; const int j = pr ? 0 : (i - nfull) * G + c;
        if (j >= 192) return false;
        int pm_, pn_; pg8::map_unit(tri, 32, 8, pm_, pn_);
        const int t = j / 12, rem = j - t * 12;
        u.pm = pr ? pm_ : 32 + (t >> 3); u.pn = pr ? pn_ : (t & 7); u.br = pr ? i % 3 : rem >> 2; u.ks = pr ? -1 : (rem & 3); return true;
    }
    __device__ __forceinline__ int nkt(const Unit& u) const { return u.ks < 0 ? 16 : 4; }
    __device__ __forceinline__ const char* aptr(const Unit& u) const { return (const char*)(A0 + (size_t)u.br * ((size_t)MT * 1024) + (size_t)u.pm * 256 * 1024 + (u.ks < 0 ? 0 : u.ks * 256)); }
    __device__ __forceinline__ const char* bptr(const Unit& u) const { return (const char*)(B0 + (size_t)u.br * 2097152 + (size_t)u.pn * 256 * 1024 + (u.ks < 0 ? 0 : u.ks * 256)); }
    __device__ __forceinline__ void a_ready(const Unit&) const {}
    __device__ __forceinline__ void done(const Unit&) const {}
};
struct SchedT {
    const bf16_t* A; const bf16_t* Bt; int K, S, G, c;
    __device__ __forceinline__ bool next(int i, Unit& u) const {
        const int L = i * G + c; const bool pr = L < 256; const int j = pr ? 0 : L - 256;
        if (j >= 16 * S) return false;
        int pm_, pn_; pg8::map_unit(pr ? L : 0, 32, 8, pm_, pn_);
        const int t = j / S;
        u.br = 0; u.pm = pr ? pm_ : 32 + (t >> 3); u.pn = pr ? pn_ : (t & 7); u.ks = pr ? -1 : j - t * S; return true;
    }
    __device__ __forceinline__ int nkt(const Unit& u) const { return u.ks < 0 ? K / 64 : (K / 64) / S; }
    __device__ __forceinline__ const char* aptr(const Unit& u) const { return (const char*)(A + (size_t)u.pm * 256 * K + (u.ks < 0 ? 0 : u.ks * ((K / 64) / S) * 64)); }
    __device__ __forceinline__ const char* bptr(const Unit& u) const { return (const char*)(Bt + (size_t)u.pn * 256 * K + (u.ks < 0 ? 0 : u.ks * ((K / 64) / S) * 64)); }
    __device__ __forceinline__ void a_ready(const Unit&) const {}
    __device__ __forceinline__ void done(const Unit&) const {}
};

struct EpiF32 {
    static constexpr bool PERM = false, AFTER_DRAIN = false;
    float* C; int ldc;
    __device__ __forceinline__ void operator()(const f32x4 (&acc)[2][2][4][2], const Unit& u, int wr, int wc, int fr, int fq) const {
        const int row0 = u.pm * 256 + wr * 64 + fr, col0 = u.pn * 256 + wc * 32 + 4 * fq;
#pragma unroll
        for (int ai = 0; ai < 2; ++ai)
#pragma unroll
            for (int m = 0; m < 4; ++m) { float* rowp = C + (size_t)(row0 + ai * 128 + m * 16) * ldc + col0;
#pragma unroll
                for (int bj = 0; bj < 2; ++bj)
#pragma unroll
                    for (int n = 0; n < 2; ++n) *(f32x4*)(rowp + bj * 128 + n * 16) = acc[ai][bj][m][n]; }
    }
};
struct EpiF32S {
    static constexpr bool PERM = true, AFTER_DRAIN = false;
    bf16_t* C; float* SL;
    __device__ __forceinline__ void operator()(const f32x4 (&acc)[2][2][4][2], const Unit& u, int wr, int wc, int fr, int fq) const {
        const int row0 = u.pm * 256 + wr * 64 + fr, col0 = u.pn * 256 + wc * 32 + 8 * fq;
        if (u.ks < 0) {
#pragma unroll
            for (int ai = 0; ai < 2; ++ai)
#pragma unroll
                for (int m = 0; m < 4; ++m)
#pragma unroll
                    for (int bj = 0; bj < 2; ++bj) { const f32x4 v0 = acc[ai][bj][m][0], v1 = acc[ai][bj][m][1];
                        u32x4 w; w.x = cvt_pk_bf16(v0[0], v0[1]); w.y = cvt_pk_bf16(v0[2], v0[3]); w.z = cvt_pk_bf16(v1[0], v1[1]); w.w = cvt_pk_bf16(v1[2], v1[3]);
                        *(u32x4*)(C + (size_t)(row0 + ai * 128 + m * 16) * 2048 + col0 + bj * 128) = w; }
        } else {
            float* base = SL + (size_t)u.ks * SLAB_ELEMS - (size_t)MP * 2048;
#pragma unroll
            for (int ai = 0; ai < 2; ++ai)
#pragma unroll
                for (int m = 0; m < 4; ++m)
#pragma unroll
                    for (int bj = 0; bj < 2; ++bj) { float* o = base + (size_t)(row0 + ai * 128 + m * 16) * 2048 + col0 + bj * 128;
                        *(f32x4*)o = acc[ai][bj][m][0]; *(f32x4*)(o + 4) = acc[ai][bj][m][1]; }
        }
    }
};
struct Epi1 {
    static constexpr bool PERM = true, AFTER_DRAIN = false;
    bf16_t* PROJ; float* MS; int skip;
    __device__ __forceinline__ void operator()(const f32x4 (&acc)[2][2][4][2], const Unit& u, int wr, int wc, int fr, int fq) const {
        if (skip) return;
        const int row0 = u.pm * 256 + wr * 64 + fr;
        if (u.br == 0) {
            if (u.pn < 8) {
                const int col = u.pn * 128 + wc * 32 + 8 * fq;
#pragma unroll
                for (int ai = 0; ai < 2; ++ai)
#pragma unroll
                    for (int m = 0; m < 4; ++m) {
                        f32x4 v0, v1;
#pragma unroll
                        for (int j = 0; j < 4; ++j) { v0[j] = acc[ai][0][m][0][j] * sigmoidf_(acc[ai][1][m][0][j]); v1[j] = acc[ai][0][m][1][j] * sigmoidf_(acc[ai][1][m][1][j]); }
                        u32x4 w; w.x = cvt_pk_bf16(v0[0], v0[1]); w.y = cvt_pk_bf16(v0[2], v0[3]); w.z = cvt_pk_bf16(v1[0], v1[1]); w.w = cvt_pk_bf16(v1[2], v1[3]);
                        __builtin_nontemporal_store(w, (u32x4*)(PROJ + (size_t)(row0 + ai * 128 + m * 16) * PW + col));
                    }
            } else {
                const int col = u.pn * 256 - 1024 + wc * 32 + 8 * fq; const bool sig = u.pn >= 28;
#pragma unroll
                for (int ai = 0; ai < 2; ++ai)
#pragma unroll
                    for (int m = 0; m < 4; ++m)
#pragma unroll
                        for (int bj = 0; bj < 2; ++bj) {
                            f32x4 v0 = acc[ai][bj][m][0], v1 = acc[ai][bj][m][1];
                            if (sig) {
#pragma unroll
                                for (int j = 0; j < 4; ++j) { v0[j] = sigmoidf_(v0[j]); v1[j] = sigmoidf_(v1[j]); } }
                            u32x4 w; w.x = cvt_pk_bf16(v0[0], v0[1]); w.y = cvt_pk_bf16(v0[2], v0[3]); w.z = cvt_pk_bf16(v1[0], v1[1]); w.w = cvt_pk_bf16(v1[2], v1[3]);
                            __builtin_nontemporal_store(w, (u32x4*)(PROJ + (size_t)(row0 + ai * 128 + m * 16) * PW + col + bj * 128));
                        }
            }
        } else {
            const int col = u.pn * 256 + wc * 32 + 8 * fq; float* ms = MS + (size_t)u.ks * MS_ELEMS;
#pragma unroll
            for (int ai = 0; ai < 2; ++ai)
#pragma unroll
                for (int m = 0; m < 4; ++m)
#pragma unroll
                    for (int bj = 0; bj < 2; ++bj) {
                        const size_t o = (size_t)(row0 + ai * 128 + m * 16) * 2048 + col + bj * 128;
                        *(f32x4*)(ms + o) = acc[ai][bj][m][0]; *(f32x4*)(ms + o + 4) = acc[ai][bj][m][1];
                    }
        }
    }
};
struct Epi4 {
    static constexpr bool PERM = true, AFTER_DRAIN = false;
    const bf16_t* PROJ; bf16_t* MERGED; const float* bpc; float* SL;
    __device__ __forceinline__ void operator()(const f32x4 (&acc)[2][2][4][2], const Unit& u, int wr, int wc, int fr, int fq) const {
        const int row0 = u.pm * 256 + wr * 64 + fr, col0 = u.pn * 256 + wc * 32 + 8 * fq;
#pragma unroll
        for (int bj = 0; bj < 2; ++bj) {
            const int col = col0 + bj * 128;
            f32x4 b0 = (f32x4){0.f, 0.f, 0.f, 0.f}, b1 = b0;
            if (u.br == 0 && u.ks <= 0) { b0 = *(const f32x4*)(bpc + col); b1 = *(const f32x4*)(bpc + col + 4); }
#pragma unroll
            for (int ai = 0; ai < 2; ++ai) {
                u32x4 g[4], pr[4];
#pragma unroll
                for (int m = 0; m < 4; ++m) { const size_t row = (size_t)(row0 + ai * 128 + m * 16);
                    g[m] = *(const u32x4*)(PROJ + row * PW + P_G + 2048 * u.br + col);
                    pr[m] = (u32x4){0u, 0u, 0u, 0u};
                    if (u.br != 0 && u.ks < 0) pr[m] = *(const u32x4*)(MERGED + row * 2048 + col); }
#pragma unroll
                for (int m = 0; m < 4; ++m) { const size_t row = (size_t)(row0 + ai * 128 + m * 16);
                    f32x4 v0 = acc[ai][bj][m][0] + b0, v1 = acc[ai][bj][m][1] + b1;
                    v0[0] *= bflo(g[m].x); v0[1] *= bfhi(g[m].x); v0[2] *= bflo(g[m].y); v0[3] *= bfhi(g[m].y);
                    v1[0] *= bflo(g[m].z); v1[1] *= bfhi(g[m].z); v1[2] *= bflo(g[m].w); v1[3] *= bfhi(g[m].w);
                    if (u.ks >= 0) { float* sp = SL + (size_t)(u.br * 4 + u.ks) * SLAB_ELEMS + (row - MP) * 2048 + col;
                        *(f32x4*)sp = v0; *(f32x4*)(sp + 4) = v1; continue; }
                    v0[0] += bflo(pr[m].x); v0[1] += bfhi(pr[m].x); v0[2] += bflo(pr[m].y); v0[3] += bfhi(pr[m].y);
                    v1[0] += bflo(pr[m].z); v1[1] += bfhi(pr[m].z); v1[2] += bflo(pr[m].w); v1[3] += bfhi(pr[m].w);
                    u32x4 w; w.x = cvt_pk_bf16(v0[0], v0[1]); w.y = cvt_pk_bf16(v0[2], v0[3]); w.z = cvt_pk_bf16(v1[0], v1[1]); w.w = cvt_pk_bf16(v1[2], v1[3]);
                    *(u32x4*)(MERGED + row * 2048 + col) = w; }
                asm volatile("" ::: "memory");
            }
        }
    }
};
struct Epi7 {
    static constexpr bool PERM = true, AFTER_DRAIN = false;
    bf16_t* HMID;
    __device__ __forceinline__ void operator()(const f32x4 (&acc)[2][2][4][2], const Unit& u, int wr, int wc, int fr, int fq) const {
        const int row0 = u.pm * 256 + wr * 64 + fr, col = u.pn * 128 + wc * 32 + 8 * fq;
#pragma unroll
        for (int ai = 0; ai < 2; ++ai)
#pragma unroll
            for (int m = 0; m < 4; ++m) {
                f32x4 v0, v1;
#pragma unroll
                for (int j = 0; j < 4; ++j) { v0[j] = siluf_(acc[ai][0][m][0][j]) * acc[ai][1][m][0][j]; v1[j] = siluf_(acc[ai][0][m][1][j]) * acc[ai][1][m][1][j]; }
                u32x4 w; w.x = cvt_pk_bf16(v0[0], v0[1]); w.y = cvt_pk_bf16(v0[2], v0[3]); w.z = cvt_pk_bf16(v1[0], v1[1]); w.w = cvt_pk_bf16(v1[2], v1[3]);
                *(u32x4*)(HMID + (size_t)(row0 + ai * 128 + m * 16) * DFF + col) = w;
            }
    }
};

__device__ __forceinline__ void tr_item(const float* __restrict__ W, int ldw, int srccol0, int k0, bf16_t* WT, int ldt, int dstrow0, LAS float* scr, int lane) {
#pragma unroll 16
    for (int i = 0; i < 64; ++i) scr[i * 65 + lane] = __builtin_nontemporal_load(W + (size_t)(k0 + i) * ldw + srccol0 + lane);
    LDS_WAIT();
    const int c = lane & 7, nn = lane >> 3;
#pragma unroll
    for (int jj = 0; jj < 8; ++jj) { const int n = nn + 8 * jj; const LAS float* s = scr + (8 * c) * 65 + n;
        u32x4 o; o.x = cvt_pk_bf16(s[0], s[65]); o.y = cvt_pk_bf16(s[130], s[195]); o.z = cvt_pk_bf16(s[260], s[325]); o.w = cvt_pk_bf16(s[390], s[455]);
        *(u32x4*)(WT + (size_t)(dstrow0 + n) * ldt + k0 + 8 * c) = o; }
    LDS_WAIT();
}
__device__ __forceinline__ void rms_row_to_bf16(const float* x, const float* g, bf16_t* o, int lane) {
    f32x4 v[8]; float ss = 0.f;
#pragma unroll
    for (int j = 0; j < 8; ++j) { v[j] = __builtin_nontemporal_load((const f32x4*)(x + 4 * lane + 256 * j)); ss += (v[j][0] * v[j][0] + v[j][1] * v[j][1]) + (v[j][2] * v[j][2] + v[j][3] * v[j][3]); }
    const float sc = rsqrtf(wave_sum(ss) * (1.f / 2048.f) + 1e-6f);
#pragma unroll
    for (int j = 0; j < 8; ++j) { const f32x4 gg = *(const f32x4*)(g + 4 * lane + 256 * j);
        u32x2 w; w.x = cvt_pk_bf16(v[j][0] * sc * gg[0], v[j][1] * sc * gg[1]); w.y = cvt_pk_bf16(v[j][2] * sc * gg[2], v[j][3] * sc * gg[3]);
        *(u32x2*)(o + 4 * lane + 256 * j) = w; }
}
__device__ __forceinline__ void phase0(KP p, LAS unsigned char* lds) {
    const int tid = ltid(), lane = tid & 63, wave = tid >> 6;
    const int gw = blockIdx.x * 8 + wave, NGW = gridDim.x * 8;
    LAS float* scr = (LAS float*)(lds + wave * 16640);
    unsigned char* ws = p->ws;
    for (int it = gw; it < 18688; it += NGW) {
        int r = it;
        if (r < 6656) { const int kb = r / 208, nb = r % 208, n0 = 64 * nb; int src;
            if (n0 < 2048) { const int tile = n0 >> 8, within = n0 & 255; src = within < 128 ? 128 * tile + within : 1024 + 128 * tile + (within - 128); }
            else if (n0 < 6144) src = n0; else src = n0 + 16;
            tr_item(p->in[9], WIN_N, src, 64 * kb, (bf16_t*)(ws + WS_WT_IN), 2048, n0, scr, lane); continue; }
        r -= 6656;
        if (r < 5632) { const int kb = r / 176, nb = r % 176, n0 = 64 * nb, tile = n0 >> 8, within = n0 & 255;
            tr_item(within < 128 ? p->in[27] : p->in[28], DFF, 128 * tile + (within & 127), 64 * kb, (bf16_t*)(ws + WS_WT_GU), 2048, n0, scr, lane); continue; }
        r -= 5632;
        if (r < 2816) { const int kb = r >> 5, nb = r & 31; tr_item(p->in[29], 2048, 64 * nb, 64 * kb, (bf16_t*)(ws + WS_WT_DN), DFF, 64 * nb, scr, lane); continue; }
        r -= 2816;
        if (r < 1024) { const int kb = r >> 5, nb = r & 31; tr_item(p->in[24], 2048, 64 * nb, 64 * kb, (bf16_t*)(ws + WS_WT_O), 2048, 64 * nb, scr, lane); continue; }
        r -= 1024;
        if (r < 1024) { const int kb = r >> 5, nb = r & 31; tr_item(p->in[22], 2048, 64 * nb, 64 * kb, (bf16_t*)(ws + WS_WT_MKV), 2048, 64 * nb, scr, lane); continue; }
        r -= 1024;
        { const int which = r >> 9, r2 = r & 511, kb = r2 >> 5, nb = r2 & 31;
          const float* W = which == 0 ? p->in[14] : (which == 1 ? p->in[20] : p->in[23]);
          bf16_t* WT = (bf16_t*)(ws + (which == 0 ? WS_WT_PC : (which == 1 ? WS_WT_PD : WS_WT_PM)));
          tr_item(W, 2048, 64 * nb, 64 * kb, WT, 1024, 64 * nb, scr, lane); }
    }
    { bf16_t* wba = (bf16_t*)(ws + WS_WT_BA); const float* win = p->in[9];
      for (int idx = blockIdx.x * 512 + tid; idx < 32768; idx += gridDim.x * 512) { const int k = idx >> 4, n = idx & 15; wba[n * 2048 + k] = f2bf(win[(size_t)k * WIN_N + 6144 + n]); } }
    for (int row = gw; row < MT + 1024; row += NGW) {
        if (row < MP) rms_row_to_bf16(p->in[0] + (size_t)row * 2048, p->in[8], (bf16_t*)(ws + WS_U) + (size_t)row * 2048, lane);
        else if (row < MT) rms_row_to_bf16(p->in[1] + (size_t)(row - MP) * 2048, p->in[8], (bf16_t*)(ws + WS_U) + (size_t)row * 2048, lane);
        else rms_row_to_bf16(p->in[2] + (size_t)(row - MT) * 2048, p->in[21], (bf16_t*)(ws + WS_MEMN) + (size_t)(row - MT) * 2048, lane);
    }
}

__device__ __forceinline__ void thin_ba(KP p) {
    const int tid = ltid(), lane = tid & 63, wave = tid >> 6, q = lane >> 4, c = lane & 15;
    const int gw = blockIdx.x * 8 + wave, NGW = gridDim.x * 8;
    const bf16_t* U = (const bf16_t*)(p->ws + WS_U); const bf16_t* WB = (const bf16_t*)(p->ws + WS_WT_BA); float* BA = (float*)(p->ws + WS_BA);
    for (int item = gw; item < 544; item += NGW) {
        const int r0 = item * 16; f32x4 acc = (f32x4){0.f, 0.f, 0.f, 0.f};
        const bf16_t* ap = U + (size_t)(r0 + c) * 2048 + 8 * q; const bf16_t* bp = WB + (size_t)c * 2048 + 8 * q;
#pragma unroll 32
        for (int s = 0; s < 64; ++s) { const bf16x8 a = *(const bf16x8*)(ap + 32 * s), b = *(const bf16x8*)(bp + 32 * s); acc = MFMA16(a, b, acc); }
#pragma unroll
        for (int r = 0; r < 4; ++r) BA[(size_t)(r0 + 4 * q + r) * 16 + c] = acc[r];
    }
}

__device__ __forceinline__ void d2_item(KP p, LAS unsigned char* lds, int item) {
    const int tid = ltid();
    const int lane = tid & 63, wave = __builtin_amdgcn_readfirstlane(tid >> 6), q = lane >> 4, cl = lane & 15;
    const int c = item & 31, h = (item >> 5) & 7, b = item >> 8;
    const int R0 = b * 2048 + c * 64;
    LAS float* R = (LAS float*)lds;
    LAS bf16_t* qb = (LAS bf16_t*)(lds + 65536);
    LAS bf16_t* kb = (LAS bf16_t*)(lds + 82944);
    LAS float* Lm = (LAS float*)(lds + 100352);
    LAS float* sm_beta = (LAS float*)(lds + 116736);
    LAS float* sm_gam = sm_beta + 64; LAS float* sm_eg = sm_beta + 128; LAS float* sm_egl = sm_beta + 192;
    LAS float* X = R;
    const bf16_t* PROJ = (const bf16_t*)(p->ws + WS_PROJ);
    unsigned char* d2 = p->ws + WS_D2 + (size_t)item * D2_BYTES;
    bf16_t* KCp = (bf16_t*)d2; bf16_t* QGp = (bf16_t*)(d2 + 16384); bf16_t* KGTp = (bf16_t*)(d2 + 32768); bf16_t* QKdp = (bf16_t*)(d2 + 49152); float* Uc = (float*)(d2 + 57344);
    unsigned rawv[3][11]; f32x2 wv4[3][4];
#pragma unroll
    for (int x = 0; x < 3; ++x) { const int ch = 1024 * x + 128 * h + 2 * lane;
#pragma unroll
        for (int j = 0; j < 4; ++j) wv4[x][j] = *(const f32x2*)(p->in[16] + j * 3072 + ch);
#pragma unroll
        for (int rr = 0; rr < 11; ++rr) { const int ti = 8 * wave + rr - 3; rawv[x][rr] = 0u;
            if (c * 64 + ti >= 0) rawv[x][rr] = __builtin_nontemporal_load((const unsigned*)(PROJ + (size_t)(R0 + ti) * PW + P_Q + ch)); } }
    __syncthreads();
    if (wave == 0) {
        const float* BA = (const float*)(p->ws + WS_BA) + (size_t)(R0 + lane) * 16;
        const float braw = BA[h], araw = BA[8 + h];
        const float beta = sigmoidf_(braw);
        const float xx = araw + p->in[18][h];
        const float sp = xx > 20.f ? xx : log1pf(expf(xx));
        const float g = -expf(p->in[17][h]) * sp;
        float gam = g;
#pragma unroll
        for (int o = 1; o < 64; o <<= 1) { const float t = __shfl_up(gam, o); if (lane >= o) gam += t; }
        const float gl = __shfl(gam, 63);
        sm_beta[lane] = beta; sm_gam[lane] = gam; sm_eg[lane] = expf(gam); sm_egl[lane] = expf(gl - gam);
        if (lane == 63) ((float*)(p->ws + WS_GL))[item] = expf(gam);
    }
    __syncthreads();
    _Pragma("unroll 1") for (int rq_ = 0; rq_ <= ((p->dup >> 22) & 1); ++rq_) {
        const int dp = lane, tg = wave;
#pragma unroll
        for (int x = 0; x < 3; ++x) {
            const int ch = 1024 * x + 128 * h + 2 * dp;
            f32x2 w[4];
#pragma unroll
            for (int j = 0; j < 4; ++j) w[j] = wv4[x][j];
            float r0[11], r1[11];
#pragma unroll
            for (int rr = 0; rr < 11; ++rr) { r0[rr] = bflo(rawv[x][rr]); r1[rr] = bfhi(rawv[x][rr]); }
            if (c == 31 && tg == 7) {
                float* o = p->out + O_DCP + (size_t)b * 3 * 3072 + ch;
#pragma unroll
                for (int k = 0; k < 3; ++k) *(f32x2*)(o + k * 3072) = (f32x2){r0[8 + k], r1[8 + k]};
            }
            float y0[8], y1[8];
#pragma unroll
            for (int ii = 0; ii < 8; ++ii) { float a0 = 0.f, a1 = 0.f;
#pragma unroll
                for (int j = 0; j < 4; ++j) { a0 += w[j][0] * r0[ii + j]; a1 += w[j][1] * r1[ii + j]; }
                y0[ii] = siluf_(a0); y1[ii] = siluf_(a1); }
            if (x < 2) {
#pragma unroll
                for (int ii = 0; ii < 8; ++ii) { const float ss = wave_sum(y0[ii] * y0[ii] + y1[ii] * y1[ii]);
                    const float sc = rsqrtf(ss + 1e-6f) * (x == 0 ? 0.08838834764831845f : 1.f); y0[ii] *= sc; y1[ii] *= sc; }
            }
            if (x == 0) {
                const int dk = 2 * dp, pos = (dk & ~31) + perm_pos(dk & 31);
#pragma unroll
                for (int ii = 0; ii < 8; ++ii) { const int i = 8 * tg + ii; const float e = sm_eg[i];
                    *(LAS unsigned*)(qb + i * 136 + 2 * dp) = cvt_pk_bf16(y0[ii], y1[ii]);
                    *(unsigned*)(QGp + i * 128 + pos) = cvt_pk_bf16(y0[ii] * e, y1[ii] * e); }
            } else if (x == 1) {
                float e[8];
#pragma unroll
                for (int ii = 0; ii < 8; ++ii) { const int i = 8 * tg + ii; e[ii] = sm_egl[i]; const float rs = sm_beta[i] * sm_eg[i];
                    *(LAS f32x2*)(R + i * 256 + 128 + 2 * dp) = (f32x2){y0[ii] * rs, y1[ii] * rs};
                    *(LAS unsigned*)(kb + i * 136 + 2 * dp) = cvt_pk_bf16(y0[ii], y1[ii]); }
                const int s = tg >> 2, pbase = (2 * (tg & 1)) * 8 + ((tg & 3) >> 1) * 4;
                { u32x2 lo, hi;
                  lo.x = cvt_pk_bf16(y0[0] * e[0], y0[1] * e[1]); lo.y = cvt_pk_bf16(y0[2] * e[2], y0[3] * e[3]);
                  hi.x = cvt_pk_bf16(y0[4] * e[4], y0[5] * e[5]); hi.y = cvt_pk_bf16(y0[6] * e[6], y0[7] * e[7]);
                  bf16_t* dst = KGTp + (2 * dp) * 64 + 32 * s + pbase; *(u32x2*)dst = lo; *(u32x2*)(dst + 8) = hi;
                  lo.x = cvt_pk_bf16(y1[0] * e[0], y1[1] * e[1]); lo.y = cvt_pk_bf16(y1[2] * e[2], y1[3] * e[3]);
                  hi.x = cvt_pk_bf16(y1[4] * e[4], y1[5] * e[5]); hi.y = cvt_pk_bf16(y1[6] * e[6], y1[7] * e[7]);
                  dst += 64; *(u32x2*)dst = lo; *(u32x2*)(dst + 8) = hi; }
            } else {
#pragma unroll
                for (int ii = 0; ii < 8; ++ii) { const int i = 8 * tg + ii; const float rs = sm_beta[i]; *(LAS f32x2*)(R + i * 256 + 2 * dp) = (f32x2){y0[ii] * rs, y1[ii] * rs}; }
            }
        }
    }
    __syncthreads();
    _Pragma("unroll 1") for (int rq_ = 0; rq_ <= ((p->dup >> 23) & 1); ++rq_) {
        const int mt = wave >> 1, nt0 = 2 * (wave & 1);
#pragma unroll
        for (int tt = 0; tt < 2; ++tt) {
            const int nt = nt0 + tt;
            f32x4 aK = (f32x4){0.f, 0.f, 0.f, 0.f}, aQ = aK;
            if (nt <= mt) {
#pragma unroll
                for (int s = 0; s < 4; ++s) {
                    const bf16x8 ak = *(const LAS bf16x8*)(kb + (16 * mt + cl) * 136 + 32 * s + 8 * q);
                    const bf16x8 aq = *(const LAS bf16x8*)(qb + (16 * mt + cl) * 136 + 32 * s + 8 * q);
                    const bf16x8 bk = *(const LAS bf16x8*)(kb + (16 * nt + cl) * 136 + 32 * s + 8 * q);
                    aK = MFMA16(ak, bk, aK); aQ = MFMA16(aq, bk, aQ);
                }
            }
            const int j = 16 * nt + cl; const float gj = sm_gam[j];
            const int pj = 32 * (nt >> 1) + ((cl >> 2) << 3) + ((nt & 1) << 2) + (cl & 3);
#pragma unroll
            for (int r = 0; r < 4; ++r) { const int i = 16 * mt + 4 * q + r;
                const float d = (j <= i) ? expf(sm_gam[i] - gj) : 0.f;
                Lm[j * 64 + i] = (j < i) ? aK[r] * sm_beta[i] * d : 0.f;
                QKdp[i * 64 + pj] = f2bf(aQ[r] * d); }
        }
    }
    __syncthreads();
    LAS float* Tt = (LAS float*)(lds + 117760);
    if (tid < 64) {
        const int Bq = tid >> 4, cq = tid & 15;
        float t[16];
#pragma unroll
        for (int i = 0; i < 16; ++i) t[i] = (i == cq) ? 1.f : 0.f;
#pragma unroll
        for (int j = 0; j < 15; ++j) { const LAS float* lc = Lm + (16 * Bq + j) * 64 + 16 * Bq;
#pragma unroll
            for (int i4 = (j + 1) / 4; i4 < 4; ++i4) { const f32x4 l4 = *(const LAS f32x4*)(lc + 4 * i4);
#pragma unroll
                for (int e = 0; e < 4; ++e) if (4 * i4 + e > j) t[4 * i4 + e] -= l4[e] * t[j]; } }
#pragma unroll
        for (int i4 = 0; i4 < 4; ++i4) *(LAS f32x4*)(Tt + Bq * 256 + cq * 16 + 4 * i4) = (f32x4){t[4 * i4], t[4 * i4 + 1], t[4 * i4 + 2], t[4 * i4 + 3]};
    } else if (tid >= 256) {
        const float* MS = (const float*)(p->ws + WS_MS);
        bf16_t* MKB = (bf16_t*)(p->ws + WS_MKB); bf16_t* MVB = (bf16_t*)(p->ws + WS_MVB);
#pragma unroll
        for (int k2 = 0; k2 < 2; ++k2) { const int idx = item * 512 + (tid - 256) + 256 * k2; const int row = idx >> 9, col = (idx & 511) * 4;
            f32x4 a = *(const f32x4*)(MS + (size_t)idx * 4);
#pragma unroll
            for (int k = 1; k < 8; ++k) a += *(const f32x4*)(MS + k * MS_ELEMS + (size_t)idx * 4);
            const bool isv = col >= 1024; const size_t o = (size_t)row * 1024 + (col & 1023);
            *(f32x4*)(p->out + (isv ? O_MV : O_MK) + o) = a;
            u32x2 w; w.x = cvt_pk_bf16(a[0], a[1]); w.y = cvt_pk_bf16(a[2], a[3]);
            *(u32x2*)((isv ? MVB : MKB) + o) = w; }
    }
    __syncthreads();
    {
        const int col0 = 32 * wave + cl;
#pragma unroll 1
        for (int B = 0; B < 4; ++B) {
            LAS float* rb = R + (16 * B + 4 * q) * 256 + col0;
            f32x4 a0, a1;
#pragma unroll
            for (int r = 0; r < 4; ++r) { a0[r] = rb[r * 256]; a1[r] = rb[r * 256 + 16]; }
            const LAS float* lp = Lm + q * 64 + 16 * B + cl; const LAS float* xp = R + q * 256 + col0;
#pragma unroll 4
            for (int s4 = 0; s4 < 4 * B; ++s4) { const float av = -lp[s4 * 256], b0 = xp[s4 * 1024], b1 = xp[s4 * 1024 + 16];
                a0 = __builtin_amdgcn_mfma_f32_16x16x4f32(av, b0, a0, 0, 0, 0); a1 = __builtin_amdgcn_mfma_f32_16x16x4f32(av, b1, a1, 0, 0, 0); }
#pragma unroll
            for (int r = 0; r < 4; ++r) { rb[r * 256] = a0[r]; rb[r * 256 + 16] = a1[r]; }
            LDS_WAIT();
            f32x4 x0 = (f32x4){0.f, 0.f, 0.f, 0.f}, x1 = x0;
            const LAS float* tp = Tt + B * 256 + q * 16 + cl; const LAS float* yp = R + (16 * B + q) * 256 + col0;
#pragma unroll
            for (int s4 = 0; s4 < 4; ++s4) { const float av = tp[s4 * 64], b0 = yp[s4 * 1024], b1 = yp[s4 * 1024 + 16];
                x0 = __builtin_amdgcn_mfma_f32_16x16x4f32(av, b0, x0, 0, 0, 0); x1 = __builtin_amdgcn_mfma_f32_16x16x4f32(av, b1, x1, 0, 0, 0); }
            LDS_WAIT();
#pragma unroll
            for (int r = 0; r < 4; ++r) { rb[r * 256] = x0[r]; rb[r * 256 + 16] = x1[r]; }
            LDS_WAIT();
        }
    }
    __syncthreads();
    _Pragma("unroll 1") for (int rq_ = 0; rq_ <= ((p->dup >> 24) & 1); ++rq_) {
#pragma unroll
    for (int k = 0; k < 2; ++k) { const int id = tid + 512 * k, i = id >> 4, p0 = (id & 15) * 8, s = p0 >> 5, q_ = (p0 & 31) >> 3;
        float v[8];
#pragma unroll
        for (int j = 0; j < 8; ++j) v[j] = X[i * 256 + 128 + 32 * s + 16 * (j >> 2) + 4 * q_ + (j & 3)];
        u32x4 w; w.x = cvt_pk_bf16(v[0], v[1]); w.y = cvt_pk_bf16(v[2], v[3]); w.z = cvt_pk_bf16(v[4], v[5]); w.w = cvt_pk_bf16(v[6], v[7]);
        *(u32x4*)(KCp + i * 128 + p0) = w; }
#pragma unroll
    for (int k = 0; k < 16; ++k) { const int idx = tid + 512 * k, w_ = idx >> 10, mt = (idx >> 8) & 3, r = (idx >> 6) & 3, ln = idx & 63;
        Uc[idx] = X[(16 * mt + 4 * (ln >> 4) + r) * 256 + 16 * w_ + (ln & 15)]; }
    }
}

template <int NT, bool SAMPLE>
__device__ __forceinline__ void conv_item(KP p, LAS unsigned char* lds, int idx) {
    const int tid = ltid();
    const int lane = tid & 63, wave = __builtin_amdgcn_readfirstlane(tid >> 6), ch = 2 * tid;
    const bf16_t* PROJ = (const bf16_t*)(p->ws + WS_PROJ);
    bf16_t* CB = (bf16_t*)(p->ws + WS_CB);
    LAS float* T = (LAS float*)lds;
    const int b = SAMPLE ? idx : (idx >> 6), t0 = SAMPLE ? 0 : (idx & 63) * 32;
    float w0[31], w1[31], P0[31], P1[31];
#pragma unroll
    for (int j = 0; j < 31; ++j) { const f32x2 wv = *(const f32x2*)(p->in[10] + j * 1024 + ch); w0[j] = wv[0]; w1[j] = wv[1]; P0[j] = 0.f; P1[j] = 0.f; }
    const f32x2 bd = *(const f32x2*)(p->in[11] + ch);
    __syncthreads();
#define CONV_STEP(x0_, x1_, r_) do { const float cx0 = (x0_), cx1 = (x1_); const int cr = (r_); \
        const float e0 = fmaf(w0[30], cx0, P0[30]), e1 = fmaf(w1[30], cx1, P1[30]); \
        _Pragma("unroll") for (int j = 30; j >= 1; --j) { P0[j] = fmaf(w0[j - 1], cx0, P0[j - 1]); P1[j] = fmaf(w1[j - 1], cx1, P1[j - 1]); asm volatile("" : "+v"(P0[j]), "+v"(P1[j])); } \
        P0[0] = 0.f; P1[0] = 0.f; \
        if (cr >= 30 && cr < NT + 30) *(LAS f32x2*)(T + (cr - 30) * 1024 + ch) = (f32x2){e0 + bd[0], e1 + bd[1]}; } while (0)
    if (SAMPLE) {
#pragma unroll 1
        for (int rb = 0; rb < 30; rb += 10) {
            f32x2 xr[10];
#pragma unroll
            for (int k = 0; k < 10; ++k) xr[k] = __builtin_nontemporal_load((const f32x2*)(p->in[5] + ((size_t)b * 30 + rb + k) * 1024 + ch));
#pragma unroll
            for (int k = 0; k < 10; ++k) { const int r = rb + k;
                if (r >= 4) *(f32x2*)(p->out + O_CS + ((size_t)b * 30 + (r - 4)) * 1024 + ch) = xr[k];
                CONV_STEP(xr[k][0], xr[k][1], r); }
        }
        unsigned xn[4];
#pragma unroll
        for (int k = 0; k < 4; ++k) xn[k] = *(const unsigned*)(PROJ + (size_t)(MP + 4 * b + k) * PW + P_GLU + ch);
#pragma unroll
        for (int k = 0; k < 4; ++k) { const float x0 = bflo(xn[k]), x1 = bfhi(xn[k]);
            *(f32x2*)(p->out + O_CS + ((size_t)b * 30 + 26 + k) * 1024 + ch) = (f32x2){x0, x1};
            CONV_STEP(x0, x1, 30 + k); }
    } else {
#pragma unroll 1
        for (int rb = 0; rb < 64; rb += 8) {
            unsigned xr[8];
#pragma unroll
            for (int k = 0; k < 8; ++k) { const int t = t0 - 30 + rb + k; xr[k] = 0u;
                if (t >= 0 && rb + k < 62) xr[k] = __builtin_nontemporal_load((const unsigned*)(PROJ + (size_t)(b * 2048 + t) * PW + P_GLU + ch)); }
#pragma unroll
            for (int k = 0; k < 8; ++k) { const int r = rb + k, t = t0 - 30 + r; const float x0 = bflo(xr[k]), x1 = bfhi(xr[k]);
                if (t >= 2018 && r < 62) *(f32x2*)(p->out + O_CP + ((size_t)b * 30 + (t - 2018)) * 1024 + ch) = (f32x2){x0, x1};
                CONV_STEP(x0, x1, r); }
        }
    }
#undef CONV_STEP
    __syncthreads();
    for (int tt = wave; tt < NT; tt += 8) {
        f32x4 v[4]; float s1 = 0.f, s2 = 0.f;
#pragma unroll
        for (int k = 0; k < 4; ++k) { v[k] = *(const LAS f32x4*)(T + tt * 1024 + 4 * lane + 256 * k);
            s1 += (v[k][0] + v[k][1]) + (v[k][2] + v[k][3]); s2 += (v[k][0] * v[k][0] + v[k][1] * v[k][1]) + (v[k][2] * v[k][2] + v[k][3] * v[k][3]); }
        s1 = wave_sum(s1); s2 = wave_sum(s2);
        const float mu = s1 * (1.f / 1024.f), var = s2 * (1.f / 1024.f) - mu * mu, rs = rsqrtf(fmaxf(var, 0.f) + 1e-5f);
        const size_t row = SAMPLE ? (size_t)(MP + 4 * b + tt) : (size_t)(b * 2048 + t0 + tt);
#pragma unroll
        for (int k = 0; k < 4; ++k) { const int c4 = 4 * lane + 256 * k;
            const f32x4 lg = *(const f32x4*)(p->in[12] + c4), lb = *(const f32x4*)(p->in[13] + c4);
            f32x4 y = (v[k] - mu) * rs * lg + lb;
            u32x2 wv; wv.x = cvt_pk_bf16(siluf_(y[0]), siluf_(y[1])); wv.y = cvt_pk_bf16(siluf_(y[2]), siluf_(y[3]));
            *(u32x2*)(CB + row * 1024 + c4) = wv; }
    }
}

__device__ __forceinline__ void sattn_item(KP p, LAS unsigned char* lds, int item) {
    const int tid = ltid();
    const int lane = tid & 63, wave = __builtin_amdgcn_readfirstlane(tid >> 6), q = lane >> 4, c = lane & 15;
    const int b = item >> 2, h = item & 3;
    const bf16_t* PROJ = (const bf16_t*)(p->ws + WS_PROJ);
    LAS float* sc = (LAS float*)lds;
    LAS float* part = (LAS float*)(lds + 4096);
    __syncthreads();
    {
        bf16x8 qf[8];
#pragma unroll
        for (int s = 0; s < 8; ++s) { u32x4 v = (u32x4){0u, 0u, 0u, 0u};
            if (c < 4) v = *(const u32x4*)(PROJ + (size_t)(MP + 4 * b + c) * PW + P_XQ + 256 * h + 32 * s + 8 * q);
            qf[s] = __builtin_bit_cast(bf16x8, v); }
#pragma unroll
        for (int tt = 0; tt < 2; ++tt) { const int kt = 2 * wave + tt;
            const float* kp = p->in[3] + ((size_t)(b * 256 + 16 * kt + c) * 4 + h) * 256 + 8 * q;
            f32x4 acc = (f32x4){0.f, 0.f, 0.f, 0.f};
#pragma unroll
            for (int s = 0; s < 8; ++s) { const f32x4 k0 = __builtin_nontemporal_load((const f32x4*)(kp + 32 * s)), k1 = __builtin_nontemporal_load((const f32x4*)(kp + 32 * s + 4)); acc = MFMA16(pack8(k0, k1), qf[s], acc); }
            if (c < 4) {
#pragma unroll
                for (int r = 0; r < 4; ++r) sc[c * 256 + 16 * kt + 4 * q + r] = acc[r] * 0.0625f; }
        }
    }
    __syncthreads();
    if (wave < 4) { f32x4 v = *(const LAS f32x4*)(sc + wave * 256 + 4 * lane);
        const float m = wave_max(fmaxf(fmaxf(v[0], v[1]), fmaxf(v[2], v[3])));
        v[0] = __expf(v[0] - m); v[1] = __expf(v[1] - m); v[2] = __expf(v[2] - m); v[3] = __expf(v[3] - m);
        const float inv = 1.f / wave_sum((v[0] + v[1]) + (v[2] + v[3]));
        *(LAS f32x4*)(sc + wave * 256 + 4 * lane) = v * inv; }
    __syncthreads();
    {
        f32x4 acc[4];
#pragma unroll
        for (int t = 0; t < 4; ++t) acc[t] = (f32x4){0.f, 0.f, 0.f, 0.f};
        const float* vp = p->in[4] + ((size_t)(b * 256 + 32 * wave) * 4 + h) * 256 + 4 * lane;
#pragma unroll 16
        for (int mm = 0; mm < 32; ++mm) { const f32x4 v = __builtin_nontemporal_load((const f32x4*)(vp + (size_t)mm * 1024));
#pragma unroll
            for (int t = 0; t < 4; ++t) acc[t] += v * sc[t * 256 + 32 * wave + mm]; }
#pragma unroll
        for (int t = 0; t < 4; ++t) *(LAS f32x4*)(part + (wave * 4 + t) * 256 + 4 * lane) = acc[t];
    }
    __syncthreads();
    { const int t = tid >> 7, d = (tid & 127) * 2; float s0 = 0.f, s1 = 0.f;
#pragma unroll
      for (int w = 0; w < 8; ++w) { const f32x2 v = *(const LAS f32x2*)(part + (w * 4 + t) * 256 + d); s0 += v[0]; s1 += v[1]; }
      *(unsigned*)((bf16_t*)(p->ws + WS_XO) + (size_t)(MP + 4 * b + t) * 1024 + 256 * h + d) = cvt_pk_bf16(s0, s1); }
}

__device__ __forceinline__ void mkv_reduce(KP p, int bx, int G) {
    const int tid = ltid();
    const float* MS = (const float*)(p->ws + WS_MS);
    bf16_t* MKB = (bf16_t*)(p->ws + WS_MKB); bf16_t* MVB = (bf16_t*)(p->ws + WS_MVB);
    for (int idx = bx * 512 + tid; idx < 1024 * 512; idx += G * 512) { const int row = idx >> 9, col = (idx & 511) * 4;
        f32x4 a = *(const f32x4*)(MS + (size_t)idx * 4);
#pragma unroll
        for (int k = 1; k < 8; ++k) a += *(const f32x4*)(MS + k * MS_ELEMS + (size_t)idx * 4);
        const bool isv = col >= 1024; const size_t o = (size_t)row * 1024 + (col & 1023);
        *(f32x4*)(p->out + (isv ? O_MV : O_MK) + o) = a;
        u32x2 w; w.x = cvt_pk_bf16(a[0], a[1]); w.y = cvt_pk_bf16(a[2], a[3]);
        *(u32x2*)((isv ? MVB : MKB) + o) = w; }
}

__device__ __forceinline__ void scan_item(KP p, LAS unsigned char* lds, int bh) {
    const int tid = ltid();
    const int lane = tid & 63, w = __builtin_amdgcn_readfirstlane(tid >> 6), q = lane >> 4, c = lane & 15;
    const float* GL = (const float*)(p->ws + WS_GL) + bh * 32;
    const unsigned char* d2 = p->ws + WS_D2 + (size_t)bh * 32 * D2_BYTES;
    unsigned char* sw = p->ws + WS_SW + ((size_t)bh * 32 * 8 + w) * 6144 + lane * 16;
    constexpr int BUF = 35840, O_KC = 0, O_KGT = 17408;
    f32x4 St[8];
#pragma unroll
    for (int i = 0; i < 8; ++i) St[i] = (f32x4){0.f, 0.f, 0.f, 0.f};
    u32x4 stg[4]; f32x4 u[4];
    __syncthreads();
#define SCAN_LOAD(chunkp) do { _Pragma("unroll") for (int k = 0; k < 2; ++k) { stg[k] = *(const u32x4*)((chunkp) + (size_t)(tid + 512 * k) * 16); stg[2 + k] = *(const u32x4*)((chunkp) + 32768 + (size_t)(tid + 512 * k) * 16); } } while (0)
#define SCAN_WRITE(bufp) do { \
        _Pragma("unroll") for (int k = 0; k < 2; ++k) { const int id = tid + 512 * k; *(LAS u32x4*)((bufp) + O_KC + (id >> 4) * 272 + (id & 15) * 16) = stg[k]; \
            *(LAS u32x4*)((bufp) + O_KGT + (id >> 3) * 144 + (id & 7) * 16) = stg[2 + k]; } } while (0)
#define SCAN_LOADU(dst, chunkp) do { const float* Uc_ = (const float*)((chunkp) + 57344); \
        _Pragma("unroll") for (int mt = 0; mt < 4; ++mt) _Pragma("unroll") for (int r = 0; r < 4; ++r) dst[mt][r] = Uc_[((w * 4 + mt) * 4 + r) * 64 + lane]; } while (0)
    f32x4 un[4]; u32x4 stg2[4];
    SCAN_LOAD(d2); SCAN_LOADU(u, d2);
    SCAN_WRITE(lds);
    SCAN_LOAD(d2 + D2_BYTES); SCAN_LOADU(un, d2 + D2_BYTES);
    const float glv = GL[lane & 31];
    __syncthreads();
#pragma unroll 1
    for (int step = 0; step < 32; ++step) {
        LAS unsigned char* cur = lds + (step & 1) * BUF; LAS unsigned char* nxt = lds + ((step + 1) & 1) * BUF;
        const bool more = step + 1 < 32, more2 = step + 2 < 32;
        const unsigned char* c2 = d2 + (size_t)(step + 2) * D2_BYTES;
        f32x4 u2[4];
        if (more2) {
#pragma unroll
            for (int k = 0; k < 2; ++k) { stg2[k] = *(const u32x4*)(c2 + (size_t)(tid + 512 * k) * 16); stg2[2 + k] = *(const u32x4*)(c2 + 32768 + (size_t)(tid + 512 * k) * 16); }
            SCAN_LOADU(u2, c2); }
        const float gl = __uint_as_float((unsigned)__builtin_amdgcn_readlane((int)__float_as_uint(glv), step));
        unsigned char* swp = sw + (size_t)step * (8 * 6144);
        bf16x8 Sb[4];
#pragma unroll
        for (int s = 0; s < 4; ++s) { Sb[s] = pack8(St[2 * s], St[2 * s + 1]); *(bf16x8*)(swp + s * 1024) = Sb[s]; }
        f32x4 W[4];
#pragma unroll
        for (int mt = 0; mt < 4; ++mt) { f32x4 a = (f32x4){0.f, 0.f, 0.f, 0.f};
#pragma unroll
            for (int s = 0; s < 4; ++s) a = MFMA16(*(const LAS bf16x8*)(cur + O_KC + (16 * mt + c) * 272 + (32 * s + 8 * q) * 2), Sb[s], a);
            W[mt] = u[mt] - a; }
        bf16x8 Wb[2];
#pragma unroll
        for (int s = 0; s < 2; ++s) { Wb[s] = pack8(W[2 * s], W[2 * s + 1]); *(bf16x8*)(swp + 4096 + s * 1024) = Wb[s]; }
#pragma unroll
        for (int i = 0; i < 8; ++i) { f32x4 a = St[i] * gl;
#pragma unroll
            for (int s = 0; s < 2; ++s) a = MFMA16(*(const LAS bf16x8*)(cur + O_KGT + (16 * i + c) * 144 + (32 * s + 8 * q) * 2), Wb[s], a);
            St[i] = a; }
        if (more) SCAN_WRITE(nxt);
        asm volatile("s_waitcnt lgkmcnt(0)" ::: "memory"); __builtin_amdgcn_s_barrier(); asm volatile("" ::: "memory");
#pragma unroll
        for (int mt = 0; mt < 4; ++mt) { u[mt] = un[mt]; if (more2) un[mt] = u2[mt]; }
        if (more2) {
#pragma unroll
            for (int k = 0; k < 4; ++k) stg[k] = stg2[k]; }
    }
#undef SCAN_LOADU
#undef SCAN_LOAD
#undef SCAN_WRITE
    float* so = p->out + O_DSP + (size_t)bh * 16384;
#pragma unroll
    for (int i = 0; i < 8; ++i)
#pragma unroll
        for (int r = 0; r < 4; ++r) so[(16 * i + 4 * q + r) * 128 + 16 * w + c] = St[i][r];
}

__device__ __forceinline__ void o_wave_item(KP p, int witem) {
    const int lane = ltid() & 63, q = lane >> 4, c = lane & 15;
    const int mh = witem & 1, item = witem >> 1, step = item & 31, bh = item >> 5, h = bh & 7, b = bh >> 3;
    const bf16_t* PROJ = (const bf16_t*)(p->ws + WS_PROJ);
    bf16_t* OD = (bf16_t*)(p->ws + WS_OD);
    const unsigned char* d2 = p->ws + WS_D2 + (size_t)item * D2_BYTES;
    const bf16_t* QGp = (const bf16_t*)(d2 + 16384); const bf16_t* QKp = (const bf16_t*)(d2 + 49152);
    const unsigned char* swp = p->ws + WS_SW + (size_t)item * 8 * 6144 + lane * 16;
    const size_t rowb = (size_t)b * 2048 + 64 * step + 32 * mh;
    bf16x8 ag[2][4], ak[2][2];
#pragma unroll
    for (int m = 0; m < 2; ++m) {
#pragma unroll
        for (int s = 0; s < 4; ++s) ag[m][s] = *(const bf16x8*)(QGp + (32 * mh + 16 * m + c) * 128 + 32 * s + 8 * q);
#pragma unroll
        for (int s = 0; s < 2; ++s) ak[m][s] = *(const bf16x8*)(QKp + (32 * mh + 16 * m + c) * 64 + 32 * s + 8 * q); }
    f32x4 O[2][8]; float ss[2][4];
    bf16_t zr[8][2][4];
#pragma unroll
    for (int nt = 0; nt < 8; ++nt)
#pragma unroll
        for (int m = 0; m < 2; ++m)
#pragma unroll
            for (int r = 0; r < 4; ++r) zr[nt][m][r] = PROJ[(rowb + 16 * m + 4 * q + r) * PW + P_Z + 128 * h + 16 * nt + c];
#pragma unroll
    for (int m = 0; m < 2; ++m)
#pragma unroll
        for (int r = 0; r < 4; ++r) ss[m][r] = 0.f;
#pragma unroll
    for (int nt = 0; nt < 8; ++nt) {
        bf16x8 Sb[4], Wb[2];
#pragma unroll
        for (int s = 0; s < 4; ++s) Sb[s] = *(const bf16x8*)(swp + nt * 6144 + s * 1024);
#pragma unroll
        for (int s = 0; s < 2; ++s) Wb[s] = *(const bf16x8*)(swp + nt * 6144 + 4096 + s * 1024);
#pragma unroll
        for (int m = 0; m < 2; ++m) { f32x4 o = (f32x4){0.f, 0.f, 0.f, 0.f};
#pragma unroll
            for (int s = 0; s < 4; ++s) o = MFMA16(ag[m][s], Sb[s], o);
#pragma unroll
            for (int s = 0; s < 2; ++s) o = MFMA16(ak[m][s], Wb[s], o);
            O[m][nt] = o;
#pragma unroll
            for (int r = 0; r < 4; ++r) ss[m][r] += o[r] * o[r]; }
    }
#pragma unroll
    for (int m = 0; m < 2; ++m)
#pragma unroll
        for (int r = 0; r < 4; ++r) { float t = ss[m][r]; t += __shfl_xor(t, 1); t += __shfl_xor(t, 2); t += __shfl_xor(t, 4); t += __shfl_xor(t, 8);
            ss[m][r] = rsqrtf(t * (1.f / 128.f) + 1e-6f); }
#pragma unroll
    for (int nt = 0; nt < 8; ++nt) { const float gdn = p->in[19][16 * nt + c];
#pragma unroll
        for (int m = 0; m < 2; ++m)
#pragma unroll
            for (int r = 0; r < 4; ++r) { const size_t row = rowb + 16 * m + 4 * q + r;
                const float z = bf2f(zr[nt][m][r]);
                OD[row * 1024 + 128 * h + 16 * nt + c] = f2bf(O[m][nt][r] * ss[m][r] * gdn * siluf_(z)); } }
}

__device__ __forceinline__ void sdelta_pair(KP p, LAS unsigned char* lds0, int item0, int item1) {
    const int tid = ltid();
    const int sub = __builtin_amdgcn_readfirstlane(tid >> 8), t8 = tid & 255, lane = tid & 63, wv = __builtin_amdgcn_readfirstlane((tid >> 6) & 3);
    const int item = sub ? item1 : item0;
    const int b = item >> 3, h = item & 7;
    const bf16_t* PROJ = (const bf16_t*)(p->ws + WS_PROJ);
    LAS unsigned char* lds = lds0 + sub * 32768;
    LAS float* qkv = (LAS float*)lds;
    LAS float* redK = (LAS float*)(lds + 8192);
    LAS float* redO = (LAS float*)(lds + 16384);
    LAS float* sm = (LAS float*)(lds + 24576);
    const int dv = t8 & 127, dg = t8 >> 7;
    const float* s0 = p->in[7] + ((size_t)(b * 8 + h) * 128 + 64 * dg) * 128 + dv;
    float S[64];
#pragma unroll
    for (int i = 0; i < 64; ++i) S[i] = __builtin_nontemporal_load(s0 + i * 128);
    __syncthreads();
    {
        float ev[6][4], wv[6][4];
#pragma unroll
        for (int k = 0; k < 6; ++k) { const int idx = t8 + 256 * k, x = idx >> 9, t = (idx >> 7) & 3, d = idx & 127;
            const int ch = 1024 * x + 128 * h + d;
#pragma unroll
            for (int j = 0; j < 4; ++j) { const int er = t + j;
                ev[k][j] = er < 3 ? p->in[6][((size_t)b * 3 + er) * 3072 + ch] : bf2f(PROJ[(size_t)(MP + 4 * b + er - 3) * PW + P_Q + ch]);
                wv[k][j] = p->in[16][j * 3072 + ch]; } }
#pragma unroll
        for (int k = 0; k < 6; ++k) { const int idx = t8 + 256 * k, x = idx >> 9, t = (idx >> 7) & 3, d = idx & 127;
            const int ch = 1024 * x + 128 * h + d;
            float y = 0.f;
#pragma unroll
            for (int j = 0; j < 4; ++j) y += wv[k][j] * ev[k][j];
            qkv[(x * 4 + t) * 128 + d] = siluf_(y);
            if (t == 3) {
#pragma unroll
                for (int kk = 0; kk < 3; ++kk) p->out[O_DCS + ((size_t)b * 3 + kk) * 3072 + ch] = ev[k][1 + kk]; }
        }
        if (t8 < 4) { const float* BA = (const float*)(p->ws + WS_BA) + (size_t)(MP + 4 * b + t8) * 16;
            const float xx = BA[8 + h] + p->in[18][h]; const float sp = xx > 20.f ? xx : log1pf(expf(xx));
            sm[t8] = sigmoidf_(BA[h]); sm[4 + t8] = expf(-expf(p->in[17][h]) * sp); }
    }
    __syncthreads();
#pragma unroll
    for (int gg = 0; gg < 2; ++gg) { const int g = wv + 4 * gg, x = g >> 2, t = g & 3; LAS float* v = qkv + (x * 4 + t) * 128 + 2 * lane;
      const float v0 = v[0], v1 = v[1]; const float sc = rsqrtf(wave_sum(v0 * v0 + v1 * v1) + 1e-6f) * (x == 0 ? 0.08838834764831845f : 1.f);
      v[0] = v0 * sc; v[1] = v1 * sc; }
    __syncthreads();
#pragma unroll
    for (int t = 0; t < 4; ++t) {
        const LAS float* kt = qkv + (4 + t) * 128 + 64 * dg; const LAS float* qt = qkv + t * 128 + 64 * dg;
        float ks = 0.f;
#pragma unroll
        for (int i4 = 0; i4 < 16; ++i4) { const f32x4 k4 = *(const LAS f32x4*)(kt + 4 * i4);
#pragma unroll
            for (int e = 0; e < 4; ++e) ks += k4[e] * S[4 * i4 + e]; }
        redK[(t * 2 + dg) * 128 + dv] = ks;
        __syncthreads();
        const float kS = redK[(t * 2 + 0) * 128 + dv] + redK[(t * 2 + 1) * 128 + dv];
        const float beta = sm[t], a = sm[4 + t];
        const float vv = beta * (qkv[(8 + t) * 128 + dv] - a * kS);
        float os = 0.f;
#pragma unroll
        for (int i4 = 0; i4 < 16; ++i4) { const f32x4 k4 = *(const LAS f32x4*)(kt + 4 * i4), q4 = *(const LAS f32x4*)(qt + 4 * i4);
#pragma unroll
            for (int e = 0; e < 4; ++e) { const int i = 4 * i4 + e; S[i] = a * S[i] + k4[e] * vv; os += q4[e] * S[i]; } }
        redO[(t * 2 + dg) * 128 + dv] = os;
    }
    float* so = p->out + O_DSS + ((size_t)(b * 8 + h) * 128 + 64 * dg) * 128 + dv;
#pragma unroll
    for (int i = 0; i < 64; ++i) __builtin_nontemporal_store(S[i], so + i * 128);
    __syncthreads();
    { const int t = wv, d = 2 * lane;
        const float o0 = redO[(t * 2 + 0) * 128 + d] + redO[(t * 2 + 1) * 128 + d], o1 = redO[(t * 2 + 0) * 128 + d + 1] + redO[(t * 2 + 1) * 128 + d + 1];
        const float sc = rsqrtf(wave_sum(o0 * o0 + o1 * o1) * (1.f / 128.f) + 1e-6f);
        const size_t row = (size_t)(MP + 4 * b + t);
        const unsigned zz = *(const unsigned*)(PROJ + row * PW + P_Z + 128 * h + 2 * lane);
        const f32x2 gd = *(const f32x2*)(p->in[19] + 2 * lane);
        *(unsigned*)((bf16_t*)(p->ws + WS_OD) + row * 1024 + 128 * h + 2 * lane) = cvt_pk_bf16(o0 * sc * gd[0] * siluf_(bflo(zz)), o1 * sc * gd[1] * siluf_(bfhi(zz))); }
}

__device__ __forceinline__ void pattn_item(KP p, LAS unsigned char* lds, int item) {
    const int tid = ltid();
    const int lane = tid & 63, w = __builtin_amdgcn_readfirstlane(tid >> 6), q = lane >> 4, c = lane & 15;
    const int b = item >> 6, h = (item >> 4) & 3, qt = item & 15;
    const bf16_t* PROJ = (const bf16_t*)(p->ws + WS_PROJ); const bf16_t* MKB = (const bf16_t*)(p->ws + WS_MKB); const bf16_t* MVB = (const bf16_t*)(p->ws + WS_MVB);
    bf16_t* XO = (bf16_t*)(p->ws + WS_XO);
    const size_t Rq = (size_t)b * 2048 + 128 * qt + 16 * w + c;
    u32x4 st[16];
#pragma unroll
    for (int k = 0; k < 16; ++k) { const int id = tid + 512 * k; st[k] = *(const u32x4*)(MKB + (size_t)(b * 256 + (id >> 5)) * 1024 + 256 * h + 8 * (id & 31)); }
    bf16x8 qf[8];
#pragma unroll
    for (int s = 0; s < 8; ++s) qf[s] = *(const bf16x8*)(PROJ + Rq * PW + P_XQ + 256 * h + 32 * s + 8 * q);
    __syncthreads();
#pragma unroll
    for (int k = 0; k < 16; ++k) { const int id = tid + 512 * k; *(LAS u32x4*)(lds + (id >> 5) * 528 + (id & 31) * 16) = st[k]; }
#pragma unroll
    for (int k = 0; k < 16; ++k) st[k] = *(const u32x4*)(MVB + (size_t)(b * 256 + 64 * (k & 3) + lane) * 1024 + 256 * h + 8 * (8 * (k >> 2) + w));
    __syncthreads();
    f32x4 acc[16];
#pragma unroll
    for (int kt = 0; kt < 16; ++kt) { f32x4 a = (f32x4){0.f, 0.f, 0.f, 0.f};
#pragma unroll
        for (int s = 0; s < 8; ++s) a = MFMA16(*(const LAS bf16x8*)(lds + (16 * kt + c) * 528 + (32 * s + 8 * q) * 2), qf[s], a);
        acc[kt] = a * 0.0625f; }
    __syncthreads();
#pragma unroll
    for (int k = 0; k < 16; ++k) { const int key = 64 * (k & 3) + lane, d0 = 8 * (8 * (k >> 2) + w), pos = (key & ~31) + perm_pos(key & 31);
        LAS bf16_t* dst = (LAS bf16_t*)lds + d0 * 264 + pos;
        dst[0 * 264] = (bf16_t)(st[k].x & 0xffffu); dst[1 * 264] = (bf16_t)(st[k].x >> 16); dst[2 * 264] = (bf16_t)(st[k].y & 0xffffu); dst[3 * 264] = (bf16_t)(st[k].y >> 16);
        dst[4 * 264] = (bf16_t)(st[k].z & 0xffffu); dst[5 * 264] = (bf16_t)(st[k].z >> 16); dst[6 * 264] = (bf16_t)(st[k].w & 0xffffu); dst[7 * 264] = (bf16_t)(st[k].w >> 16); }
    float m = -3.0e38f;
#pragma unroll
    for (int kt = 0; kt < 16; ++kt) m = fmaxf(m, fmaxf(fmaxf(acc[kt][0], acc[kt][1]), fmaxf(acc[kt][2], acc[kt][3])));
    m = fmaxf(m, __shfl_xor(m, 16)); m = fmaxf(m, __shfl_xor(m, 32));
    float sum = 0.f;
#pragma unroll
    for (int kt = 0; kt < 16; ++kt) {
#pragma unroll
        for (int r = 0; r < 4; ++r) { acc[kt][r] = __expf(acc[kt][r] - m); sum += acc[kt][r]; } }
    sum += __shfl_xor(sum, 16); sum += __shfl_xor(sum, 32);
    const float inv = 1.f / sum;
    bf16x8 Pb[8];
#pragma unroll
    for (int s = 0; s < 8; ++s) Pb[s] = pack8(acc[2 * s] * inv, acc[2 * s + 1] * inv);
    __syncthreads();
#pragma unroll 4
    for (int dt = 0; dt < 16; ++dt) { f32x4 o = (f32x4){0.f, 0.f, 0.f, 0.f};
#pragma unroll
        for (int s = 0; s < 8; ++s) o = MFMA16(*(const LAS bf16x8*)(lds + (16 * dt + c) * 528 + (32 * s + 8 * q) * 2), Pb[s], o);
        u32x2 wv; wv.x = cvt_pk_bf16(o[0], o[1]); wv.y = cvt_pk_bf16(o[2], o[3]);
        *(u32x2*)(XO + Rq * 1024 + 256 * h + 16 * dt + 4 * q) = wv; }
}

template <int NS>
__device__ __forceinline__ void load_row(KP p, int row, int lane, f32x4 (&v)[8]) {
    if (row < MP) { const bf16_t* src = (const bf16_t*)(p->ws + WS_D2) + (size_t)row * 2048 + 8 * lane;
#pragma unroll
        for (int j = 0; j < 4; ++j) { const u32x4 w = *(const u32x4*)(src + 512 * j);
            v[2 * j] = (f32x4){bflo(w.x), bfhi(w.x), bflo(w.y), bfhi(w.y)}; v[2 * j + 1] = (f32x4){bflo(w.z), bfhi(w.z), bflo(w.w), bfhi(w.w)}; }
    } else { const float* sl = (const float*)(p->ws + WS_SL) + (size_t)(row - MP) * 2048 + 8 * lane;
#pragma unroll
        for (int j2 = 0; j2 < 8; ++j2) v[j2] = *(const f32x4*)(sl + 512 * (j2 >> 1) + 4 * (j2 & 1));
#pragma unroll 1
        for (int k = 1; k < NS; ++k) {
#pragma unroll
            for (int j2 = 0; j2 < 8; ++j2) v[j2] += *(const f32x4*)(sl + k * SLAB_ELEMS + 512 * (j2 >> 1) + 4 * (j2 & 1)); } }
}
__device__ __forceinline__ void rowpass1(KP p) {
    const int tid = ltid(), lane = tid & 63, wave = tid >> 6;
    const int gw = blockIdx.x * 8 + wave, NGW = gridDim.x * 8;
    bf16_t* F = (bf16_t*)(p->ws + WS_CB);
    f32x4 vn[8]; if (gw < MT) load_row<8>(p, gw, lane, vn);
    for (int row = gw; row < MT; row += NGW) {
        const float* xr = (row < MP ? p->in[0] + (size_t)row * 2048 : p->in[1] + (size_t)(row - MP) * 2048) + 8 * lane;
        float* yo = p->out + O_Y + (size_t)row * 2048 + 8 * lane;
        f32x4 v[8];
#pragma unroll
        for (int j = 0; j < 8; ++j) v[j] = vn[j];
        if (row + NGW < MT) load_row<8>(p, row + NGW, lane, vn);
        float ss = 0.f;
#pragma unroll
        for (int j = 0; j < 8; ++j) ss += (v[j][0] * v[j][0] + v[j][1] * v[j][1]) + (v[j][2] * v[j][2] + v[j][3] * v[j][3]);
        const float sc = rsqrtf(wave_sum(ss) * (1.f / 2048.f) + 1e-6f);
        float s2 = 0.f;
#pragma unroll
        for (int j = 0; j < 8; ++j) { const int co = 512 * (j >> 1) + 4 * (j & 1);
            const f32x4 g = *(const f32x4*)(p->in[25] + 8 * lane + co), xx = *(const f32x4*)(xr + co);
            v[j] = xx + v[j] * sc * g; *(f32x4*)(yo + co) = v[j];
            s2 += (v[j][0] * v[j][0] + v[j][1] * v[j][1]) + (v[j][2] * v[j][2] + v[j][3] * v[j][3]); }
        const float sc2 = rsqrtf(wave_sum(s2) * (1.f / 2048.f) + 1e-6f);
#pragma unroll
        for (int j = 0; j < 4; ++j) { const f32x4 g0 = *(const f32x4*)(p->in[26] + 8 * lane + 512 * j), g1 = *(const f32x4*)(p->in[26] + 8 * lane + 512 * j + 4);
            const f32x4 a = v[2 * j] * sc2 * g0, c = v[2 * j + 1] * sc2 * g1;
            u32x4 w; w.x = cvt_pk_bf16(a[0], a[1]); w.y = cvt_pk_bf16(a[2], a[3]); w.z = cvt_pk_bf16(c[0], c[1]); w.w = cvt_pk_bf16(c[2], c[3]);
            *(u32x4*)(F + (size_t)row * 2048 + 8 * lane + 512 * j) = w; }
    }
}
__device__ __forceinline__ void rowpass2(KP p) {
    const int tid = ltid(), lane = tid & 63, wave = tid >> 6;
    const int gw = blockIdx.x * 8 + wave, NGW = gridDim.x * 8;
    f32x4 vn[8]; if (gw < MT) load_row<11>(p, gw, lane, vn);
    for (int row = gw; row < MT; row += NGW) {
        float* yo = p->out + O_Y + (size_t)row * 2048 + 8 * lane;
        f32x4 v[8];
#pragma unroll
        for (int j = 0; j < 8; ++j) v[j] = vn[j];
        if (row + NGW < MT) load_row<11>(p, row + NGW, lane, vn);
        float ss = 0.f;
#pragma unroll
        for (int j = 0; j < 8; ++j) ss += (v[j][0] * v[j][0] + v[j][1] * v[j][1]) + (v[j][2] * v[j][2] + v[j][3] * v[j][3]);
        const float sc = rsqrtf(wave_sum(ss) * (1.f / 2048.f) + 1e-6f);
#pragma unroll
        for (int j = 0; j < 8; ++j) { const int co = 512 * (j >> 1) + 4 * (j & 1);
            const f32x4 g = *(const f32x4*)(p->in[30] + 8 * lane + co), hh = *(const f32x4*)(yo + co);
            __builtin_nontemporal_store(hh + v[j] * sc * g, (f32x4*)(yo + co)); }
    }
}

#define XB_TMO      128
#define XB_XCNT(j)  (256  + 64 * (j))
#define XB_XSUB(j)  (1280 + 64 * (j))
#define XB_XGEN(j)  (2304 + 64 * (j))
#define XB_TOP      3328
#define XB_TOPGEN   3392
#define XCD_BAR_WORDS 3456
#define XB_SPIN_CAP (1u << 18)

__device__ __forceinline__ unsigned xb_ld(unsigned* p)              { return __hip_atomic_load(p, __ATOMIC_RELAXED, __HIP_MEMORY_SCOPE_AGENT); }
__device__ __forceinline__ unsigned xb_add(unsigned* p, unsigned v) { return __hip_atomic_fetch_add(p, v, __ATOMIC_RELAXED, __HIP_MEMORY_SCOPE_AGENT); }
__device__ __forceinline__ unsigned xb_xcc_id() { return (unsigned)__builtin_amdgcn_s_getreg((3 << 11) | 20) & 0xFu; }
#define XB_SPIN(cond, bar) do { unsigned _sp = 0; while (cond) { __builtin_amdgcn_s_sleep(1); \
    if ((++_sp & 255u) == 0u) { if (xb_ld(&(bar)[XB_TMO])) break; if (_sp > XB_SPIN_CAP) { atomicAdd(&(bar)[XB_TMO], 1u); break; } } } } while (0)

struct XcdBarrier {
    unsigned* bar; unsigned x;
    volatile LAS unsigned* st;
};

__device__ __forceinline__ XcdBarrier xcd_barrier_post(unsigned* bar, volatile LAS unsigned* st) {
    XcdBarrier b; b.bar = bar; b.x = xb_xcc_id(); b.st = st;
    if (threadIdx.x == 0) (void)xb_add(&bar[XB_XCNT(b.x)], 1u);
    return b;
}
__device__ __forceinline__ void xcd_barrier_complete(unsigned* bar, unsigned x, unsigned& nloc, unsigned& nx) {
    const unsigned G = gridDim.x * gridDim.y * gridDim.z;
    unsigned sum, cnt, mine, sp = 0u;
    for (;;) {
        sum = 0u; cnt = 0u; mine = 0u;
#pragma unroll
        for (unsigned j = 0; j < 16; ++j) { const unsigned c = xb_ld(&bar[XB_XCNT(j)]); sum += c; cnt += (c > 0u) ? 1u : 0u; mine = (j == x) ? c : mine; }
        if (sum == G) break;
        __builtin_amdgcn_s_sleep(1);
        if ((++sp & 255u) == 0u) { if (xb_ld(&bar[XB_TMO])) break; if (sp > XB_SPIN_CAP) { atomicAdd(&bar[XB_TMO], 1u); break; } }
    }
    nloc = mine > 0u ? mine : 1u; nx = cnt > 0u ? cnt : 1u;
}

__device__ __forceinline__ void xcd_barrier(const XcdBarrier& b) {
    asm volatile("s_waitcnt vmcnt(0)" ::: "memory");
    __syncthreads();
    if (threadIdx.x == 0) {
        unsigned* bar = b.bar;
        __builtin_amdgcn_s_waitcnt(0);
        unsigned nloc = b.st[0], nx = b.st[1];
        if (nloc == 0u) { xcd_barrier_complete(bar, b.x, nloc, nx); b.st[0] = nloc; b.st[1] = nx; }
        const unsigned old = xb_add(&bar[XB_XSUB(b.x)], 1u);
        const unsigned gen = old / nloc;
        if (old + 1u == (gen + 1u) * nloc) {
            __builtin_amdgcn_fence(__ATOMIC_RELEASE, "agent");
            asm volatile("s_waitcnt vmcnt(0)" ::: "memory");
            const unsigned og = xb_add(&bar[XB_TOP], 1u);
            const unsigned tg = og / nx;
            if (og + 1u == (tg + 1u) * nx) xb_add(&bar[XB_TOPGEN], 1u);
            else XB_SPIN(xb_ld(&bar[XB_TOPGEN]) == tg, bar);
            __builtin_amdgcn_fence(__ATOMIC_ACQUIRE, "agent");
            xb_add(&bar[XB_XGEN(b.x)], 1u);
            asm volatile("s_waitcnt vmcnt(0)" ::: "memory");
        } else {
            XB_SPIN(xb_ld(&bar[XB_XGEN(b.x)]) == gen, bar);
            __builtin_amdgcn_fence(__ATOMIC_ACQUIRE, "agent");
            asm volatile("s_waitcnt vmcnt(0)" ::: "memory");
        }
    }
    __syncthreads();
}

__global__ void __launch_bounds__(512, 2) mega_fwd(Params p_unused) {
#define p kparams()
    extern __shared__ __attribute__((aligned(16))) unsigned char lds_raw[];
    LAS unsigned char* lds = (LAS unsigned char*)lds_raw;
    cg::grid_group grid = cg::this_grid();
    const int lo = p->ph_lo, hi = p->ph_hi, G = gridDim.x, bx = blockIdx.x;
    unsigned char* ws = p->ws;
#ifndef PH_MASK
#define PH_MASK 0x3ff
#endif
#define IN(k) ((((PH_MASK) >> (k)) & 1) && lo <= (k) && (k) < hi)
#define REP(k) _Pragma("unroll 1") for (int rep_ = 0; rep_ <= ((p->dup >> (k)) & 1); ++rep_)
#define SEAM(k) do { if (IN(k) && IN((k) + 1)) _Pragma("unroll 1") for (int sr_ = 0; sr_ <= ((p->dup >> 20) & 1); ++sr_) { xcd_barrier(bar); } } while (0)
    for (int u = ltid(); u < 64; u += 512) ((LAS unsigned*)(lds + 147200))[u] = 0u;
    __syncthreads();
    XcdBarrier bar = xcd_barrier_post((unsigned*)(ws + WS_BAR), (volatile LAS unsigned*)(lds + 147200));
    if (hi > 1000) grid.sync();
    if (IN(0)) REP(0) { __syncthreads(); phase0(p, lds); }
    SEAM(0);
    if (IN(1)) REP(1) {
        Sched1 S{(const bf16_t*)(ws + WS_U), (const bf16_t*)(ws + WS_WT_IN), (const bf16_t*)(ws + WS_MEMN), (const bf16_t*)(ws + WS_WT_MKV), G, bx};
        Epi1 E{(bf16_t*)(ws + WS_PROJ), (float*)(ws + WS_MS), (rep_ == 1 && ((p->dup >> 21) & 1)) ? 1 : 0};
        pg8::gemm_phase<Epi1, Sched1, true, true>(lds, 2048, S, E);
        thin_ba(p);
    }
    SEAM(1);
    if (IN(2)) REP(2) {
#ifndef P2_MASK
#define P2_MASK 31
#endif
#define REPI(k) _Pragma("unroll 1") for (int repi_ = 0; repi_ <= ((p->dup >> (k)) & 1); ++repi_)
        if (P2_MASK & 1) REPI(10) for (int it = bx; it < 1024; it += G) d2_item(p, lds, it);
        if (P2_MASK & 2) REPI(11) for (int it = bx; it < 256; it += G) conv_item<32, false>(p, lds, it);
        if (P2_MASK & 4) REPI(12) for (int it = bx; it < 128; it += G) conv_item<4, true>(p, lds, it);
        if (P2_MASK & 8) REPI(13) for (int it = bx; it < 512; it += G) sattn_item(p, lds, it);
    }
    SEAM(2);
    if (IN(3)) REP(3) {
#ifndef P3_MASK
#define P3_MASK 7
#endif
        if (bx < 32) { if (P3_MASK & 1) REPI(14) scan_item(p, lds, bx); }
        else {
            const int j = bx - 32, nb = G - 32;
            if (P3_MASK & 2) REPI(15) for (int it = j; it < 256; it += nb) pattn_item(p, lds, it);
            if (nb == 224) { const int n0 = j < 32 ? 2 : 5, s0 = j < 32 ? 2 * j : 64 + 5 * (j - 32);
                if (P3_MASK & 4) REPI(16) for (int it = 0; it < n0; it += 2) sdelta_pair(p, lds, s0 + it, s0 + (it + 1 < n0 ? it + 1 : it)); }
            else { if (P3_MASK & 4) REPI(16) for (int it = j; it < 1024; it += nb) sdelta_pair(p, lds, it, it); }
        }
        xcd_barrier(bar);
        REPI(17) for (int it = bx * 8 + (ltid() >> 6); it < 2048; it += G * 8) o_wave_item(p, __builtin_amdgcn_readfirstlane(it));
    }
    SEAM(3);
    if (IN(4)) REP(4) {
        Sched4 S{(const bf16_t*)(ws + WS_CB), (const bf16_t*)(ws + WS_WT_PC), G, bx};
        Epi4 E{(const bf16_t*)(ws + WS_PROJ), (bf16_t*)(ws + WS_U), p->in[15], (float*)(ws + WS_SL)};
        pg8::gemm_phase<Epi4, Sched4, true, true>(lds, 1024, S, E);
        xcd_barrier(bar);
        {
            const float* SL = (const float*)(ws + WS_SL); bf16_t* MG = (bf16_t*)(ws + WS_U) + (size_t)MP * 2048;
            for (int idx = bx * 512 + ltid(); idx < (int)(SLAB_ELEMS / 8); idx += G * 512) {
                f32x4 a0 = *(const f32x4*)(SL + (size_t)idx * 8), a1 = *(const f32x4*)(SL + (size_t)idx * 8 + 4);
#pragma unroll
                for (int sl = 1; sl < 12; ++sl) { a0 += *(const f32x4*)(SL + sl * SLAB_ELEMS + (size_t)idx * 8); a1 += *(const f32x4*)(SL + sl * SLAB_ELEMS + (size_t)idx * 8 + 4); }
                u32x4 w; w.x = cvt_pk_bf16(a0[0], a0[1]); w.y = cvt_pk_bf16(a0[2], a0[3]); w.z = cvt_pk_bf16(a1[0], a1[1]); w.w = cvt_pk_bf16(a1[2], a1[3]);
                *(u32x4*)(MG + (size_t)idx * 8) = w; }
        }
    }
    SEAM(4);
    if (IN(5)) REP(5) {
        SchedT S{(const bf16_t*)(ws + WS_U), (const bf16_t*)(ws + WS_WT_O), 2048, 8, G, bx};
        EpiF32S E{(bf16_t*)(ws + WS_D2), (float*)(ws + WS_SL)};
        pg8::gemm_phase<EpiF32S, SchedT, true, true>(lds, 2048, S, E);
    }
    SEAM(5);
    if (IN(6)) REP(6) rowpass1(p);
    SEAM(6);
    if (IN(7)) REP(7) {
        SchedG S{(const bf16_t*)(ws + WS_CB), (const bf16_t*)(ws + WS_WT_GU), 34, 44, 2048, G, bx};
        Epi7 E{(bf16_t*)(ws + WS_PROJ)};
        pg8::gemm_phase<Epi7, SchedG, true, true>(lds, 2048, S, E);
    }
    SEAM(7);
    if (IN(8)) REP(8) {
        SchedT S{(const bf16_t*)(ws + WS_PROJ), (const bf16_t*)(ws + WS_WT_DN), DFF, 11, G, bx};
        EpiF32S E{(bf16_t*)(ws + WS_D2), (float*)(ws + WS_SL)};
        pg8::gemm_phase<EpiF32S, SchedT, true, true>(lds, DFF, S, E);
    }
    SEAM(8);
    if (IN(9)) rowpass2(p);
#ifdef MK_DBG
#ifndef MK_DBG_ROWS
#define MK_DBG_ROWS 0
#endif
    { asm volatile("s_waitcnt vmcnt(0) lgkmcnt(0)" ::: "memory"); __syncthreads(); grid.sync();
      if (threadIdx.x < 64) { __builtin_amdgcn_fence(__ATOMIC_ACQUIRE, "agent"); asm volatile("s_waitcnt vmcnt(0)" ::: "memory"); } __syncthreads();
      const bf16_t* s0 = (const bf16_t*)(ws + (MK_DBG == 1 ? WS_CB : (MK_DBG == 2 ? WS_XO : WS_U)));
      const bf16_t* s1 = (const bf16_t*)(ws + (MK_DBG == 1 ? WS_OD : (MK_DBG == 2 ? WS_XO : WS_U)));
      for (size_t i = (size_t)bx * 512 + threadIdx.x; i < (size_t)MT * 2048; i += (size_t)G * 512) { const size_t row = i >> 11; const int col = (int)(i & 2047);
          float v; if (MK_DBG == 3) v = bf2f(s0[row * 2048 + col]); else v = col < 1024 ? bf2f(s0[row * 1024 + col]) : bf2f(s1[row * 1024 + col - 1024]);
          if (MK_DBG == 2 && (MK_DBG_ROWS == 1 ? row >= MP : row < MP)) v = 0.f;
          p->out[O_Y + i] = v; } }
#endif
#undef IN
#undef SEAM
#undef p
}

#ifndef MK_N_LAUNCHES
#define MK_N_LAUNCHES 1
#endif
extern "C" void kernel_launch(void* const* d_in, const int* in_sizes, int n_in, void* d_out, int out_size, void* d_ws, size_t ws_size, hipStream_t stream) {
    static int grid = 0;
    if (grid == 0) {
        if (n_in != 31 || ws_size < WS_END) { fprintf(stderr, "kernel_launch: unexpected inputs (n_in %d, ws %zu, need %zu)\n", n_in, ws_size, (size_t)WS_END); grid = -1; return; }
        int dev = 0, cus = 0, per_cu = 0;
        (void)hipGetDevice(&dev); (void)hipDeviceGetAttribute(&cus, hipDeviceAttributeMultiprocessorCount, dev);
        if (hipFuncSetAttribute((const void*)mega_fwd, hipFuncAttributeMaxDynamicSharedMemorySize, LDS_BYTES) != hipSuccess) { fprintf(stderr, "kernel_launch: hipFuncSetAttribute failed\n"); grid = -1; return; }
        (void)hipOccupancyMaxActiveBlocksPerMultiprocessor(&per_cu, (const void*)mega_fwd, 512, LDS_BYTES);
        (void)hipGetLastError();
        if (per_cu < 1) { fprintf(stderr, "kernel_launch: occupancy query says %d blocks per CU\n", per_cu); per_cu = 1; }
        grid = cus;
    }
    if (grid < 0) return;
    (void)hipMemsetAsync((char*)d_ws + WS_BAR, 0, XCD_BAR_WORDS * 4, stream);
    Params a{};
    for (int i = 0; i < 31; ++i) a.in[i] = (const float*)d_in[i];
    a.out = (float*)d_out; a.ws = (unsigned char*)d_ws;
#if MK_N_LAUNCHES == 1
#ifndef MK_PH_HI
#define MK_PH_HI 10
#endif
#ifndef DUP_MASK
#define DUP_MASK 0
#endif
    a.ph_lo = 0; a.ph_hi = MK_PH_HI; a.dup = DUP_MASK;
    if (MK_PH_HI < 10) (void)hipMemsetAsync(d_out, 0, (size_t)out_size * 4, stream);
    void* args[] = {&a};
    hipError_t e = hipLaunchCooperativeKernel((const void*)mega_fwd, dim3(grid), dim3(512), args, LDS_BYTES, stream);
    if (e != hipSuccess) fprintf(stderr, "cooperative launch failed: %s (grid %d)\n", hipGetErrorString(e), grid);
#else
    for (int ph = 0; ph < 10; ++ph) { a.ph_lo = ph; a.ph_hi = ph + 1; hipLaunchKernelGGL(mega_fwd, dim3(grid), dim3(512), LDS_BYTES, stream, a); }
#endif
}
```

```cpp
#include <hip/hip_runtime.h>
#include <hip/hip_cooperative_groups.h>
#include <cstdio>
#include <cstdint>
namespace cg = cooperative_groups;

#define LAS __attribute__((address_space(3)))
typedef unsigned short bf16_t;
typedef short bf16x8 __attribute__((ext_vector_type(8)));
typedef float f32x4 __attribute__((ext_vector_type(4)));
typedef float f32x2 __attribute__((ext_vector_type(2)));
typedef unsigned u32x4 __attribute__((ext_vector_type(4)));
typedef unsigned u32x2 __attribute__((ext_vector_type(2)));

constexpr int DM = 2048, MT = 8704, MP = 8192, PW = 12288;
constexpr int P_GLU = 0, P_Q = 1024, P_Z = 4096, P_XQ = 5120, P_G = 6144;
constexpr int WIN_N = 13328, DFF = 5632;
constexpr size_t O_Y = 0, O_MK = 17825792, O_MV = 18874368, O_CP = 19922944, O_DCP = 20045824, O_DSP = 20082688, O_CS = 20606976, O_DCS = 24539136, O_DSS = 25718784;
constexpr size_t WS_WT_IN = 0;
constexpr size_t WS_WT_BA = WS_WT_IN + (size_t)13312 * 2048 * 2;
constexpr size_t WS_WT_PC = WS_WT_BA + 65536;
constexpr size_t WS_WT_PD = WS_WT_PC + 4194304;
constexpr size_t WS_WT_PM = WS_WT_PD + 4194304;
constexpr size_t WS_WT_O = WS_WT_PM + 4194304;
constexpr size_t WS_WT_MKV = WS_WT_O + 8388608;
constexpr size_t WS_WT_GU = WS_WT_MKV + 8388608;
constexpr size_t WS_WT_DN = WS_WT_GU + (size_t)11264 * 2048 * 2;
constexpr size_t WS_U = WS_WT_DN + (size_t)2048 * 5632 * 2;
constexpr size_t WS_MEMN = WS_U + (size_t)MT * 2048 * 2;
constexpr size_t WS_PROJ = WS_MEMN + 4194304;
constexpr size_t WS_BA = WS_PROJ + (size_t)MT * PW * 2;
constexpr size_t WS_MKB = WS_BA + (size_t)MT * 16 * 4;
constexpr size_t WS_MVB = WS_MKB + 2097152;
constexpr size_t WS_MVT = WS_MVB + 2097152;
constexpr size_t WS_CB = WS_MVT + 2097152;
constexpr size_t WS_OD = WS_CB + (size_t)MT * 1024 * 2;
constexpr size_t WS_XO = WS_OD + (size_t)MT * 1024 * 2;
constexpr size_t WS_D2 = WS_XO + (size_t)MT * 1024 * 2;
constexpr size_t D2_BYTES = 90112;
constexpr size_t WS_GL = WS_D2 + (size_t)1024 * D2_BYTES;
constexpr size_t WS_BAR = WS_GL + 4096;
constexpr size_t WS_SL = WS_BAR + 16384;
constexpr size_t SLAB_ELEMS = (size_t)512 * 2048;
constexpr size_t WS_SW = WS_SL + 12 * SLAB_ELEMS * 4;
constexpr size_t WS_END = WS_SW + (size_t)1024 * 8 * 6144;
constexpr size_t WS_MS = WS_SL;
constexpr size_t MS_ELEMS = (size_t)1024 * 2048;
static_assert(WS_MS + 8 * MS_ELEMS * 4 <= WS_END, "mem_kv slabs must fit the SL | SW regions");
constexpr int LDS_BYTES = 147456;

struct Params { const float* in[31]; float* out; unsigned char* ws; int ph_lo, ph_hi, dup, pad; };
typedef const __attribute__((address_space(4))) Params* KP;
__device__ __forceinline__ KP kparams() { KP k = (KP)__builtin_amdgcn_kernarg_segment_ptr(); asm volatile("" : "+s"(k)); return k; }

typedef __bf16 v2bf_t __attribute__((ext_vector_type(2)));
__device__ __forceinline__ unsigned cvt_pk_bf16(float lo, float hi) { const f32x2 f = {lo, hi}; const v2bf_t r = __builtin_convertvector(f, v2bf_t); return __builtin_bit_cast(unsigned, r); }
__device__ __forceinline__ float bflo(unsigned w) { return __uint_as_float(w << 16); }
__device__ __forceinline__ float bfhi(unsigned w) { return __uint_as_float(w & 0xffff0000u); }
__device__ __forceinline__ float bf2f(bf16_t b) { return __uint_as_float(((unsigned)b) << 16); }
__device__ __forceinline__ bf16_t f2bf(float f) { return (bf16_t)(cvt_pk_bf16(f, 0.f) & 0xffffu); }
__device__ __forceinline__ float sigmoidf_(float x) { return __builtin_amdgcn_rcpf(1.f + __expf(-x)); }
__device__ __forceinline__ float siluf_(float x) { return x * sigmoidf_(x); }
__device__ __forceinline__ float wave_sum(float v) {
#pragma unroll
    for (int o = 1; o < 64; o <<= 1) v += __shfl_xor(v, o);
    return v;
}
__device__ __forceinline__ float wave_max(float v) {
#pragma unroll
    for (int o = 1; o < 64; o <<= 1) v = fmaxf(v, __shfl_xor(v, o));
    return v;
}
__device__ __forceinline__ bf16x8 pack8(f32x4 a, f32x4 b) {
    u32x4 w; w.x = cvt_pk_bf16(a[0], a[1]); w.y = cvt_pk_bf16(a[2], a[3]); w.z = cvt_pk_bf16(b[0], b[1]); w.w = cvt_pk_bf16(b[2], b[3]);
    return __builtin_bit_cast(bf16x8, w);
}
__device__ __forceinline__ int ltid() { int t = threadIdx.x; asm volatile("" : "+v"(t)); return t; }
#define LDS_WAIT() asm volatile("s_waitcnt lgkmcnt(0)" ::: "memory")
#define MFMA16(a, b, c) __builtin_amdgcn_mfma_f32_16x16x32_bf16((a), (b), (c), 0, 0, 0)
__device__ __forceinline__ int perm_off(int p) { return 16 * ((p & 7) >> 2) + 4 * (p >> 3) + (p & 3); }
__device__ __forceinline__ int perm_pos(int o) { return (((o >> 2) & 3) << 3) | ((o >> 4) << 2) | (o & 3); }

namespace pg8 {
#define PG8_LAS __attribute__((address_space(3)))
constexpr int BM = 256, BK = 64, HALF = 128, HTB = HALF * BK * 2, STAGE_BYTES = 8 * HTB, NXCD = 8, WGM = 8;
__host__ __device__ __forceinline__ int lds_byte(int r, int c) { const int st = (r >> 4) * 2 + (c >> 5), rr = r & 15, cc = c & 31, ob = rr * 64 + cc * 2; return st * 1024 + (ob ^ (((ob >> 9) & 1) << 5)); }
__host__ __device__ __forceinline__ void stage_rc(int b, int& R, int& C) { const int st = b / 1024, sb = b % 1024, swz = sb ^ (((sb >> 9) & 1) << 5); R = (st >> 1) * 16 + swz / 64; C = (st & 1) * 32 + (swz % 64) / 2; }
__host__ __device__ __forceinline__ int perm32(int rho) { const int n = rho >> 4, i = rho & 15; return 8 * (i >> 2) + 4 * n + (i & 3); }
struct Unit { int pm, pn, br, ks; };
__device__ __forceinline__ void map_unit(int L, int nM, int nN, int& pm, int& pn) {
    const int nwg = nM * nN; int wgid = L;
    { const int q = nwg / NXCD, r = nwg % NXCD, xcd = wgid % NXCD, off = wgid / NXCD; wgid = (xcd < r ? xcd * (q + 1) : r * (q + 1) + (xcd - r) * q) + off; }
    const int nig = WGM * nN, gid = wgid / nig, fm = gid * WGM, gsz = (nM - fm) < WGM ? (nM - fm) : WGM;
    pm = fm + ((wgid % nig) % gsz); pn = (wgid % nig) / gsz;
}
template <class Epi, class Sched, bool ALIGN_EPI = false, bool SP2 = false>
__device__ __forceinline__ void gemm_phase(PG8_LAS unsigned char* lds, const int K_, const Sched& S, const Epi& E) {
    const int tid = ltid(), wid = __builtin_amdgcn_readfirstlane(tid >> 6), lane = tid & 63, wr = wid >> 2, wc = wid & 3, fr = lane & 15, fq = lane >> 4;
    const int K = K_; int nt = K / BK;
    unsigned voffA[2], voffB[2];
#pragma unroll
    for (int i = 0; i < 2; ++i) { int R, C; stage_rc(tid * 16 + i * 8192, R, C); const int Rb = Epi::PERM ? ((R & ~31) + perm32(R & 31)) : R;
        voffA[i] = (unsigned)(R * K + C) * 2u; voffB[i] = (unsigned)(Rb * K + C) * 2u; }
    const size_t kstep = (size_t)(BK * 2);
    const size_t hstep = (size_t)HALF * K * 2;
    const size_t tstep = 2 * hstep;
    const unsigned ldsw = (unsigned)wid * 1024u;
    const int aoff = lds_byte(wr * 64 + fr, fq * 8), boff = lds_byte(wc * 32 + fr, fq * 8);
#define PG8_SA(b, h) (((b) * 2 + (h)) * HTB)
#define PG8_SB(b, h) ((4 + (b) * 2 + (h)) * HTB)
#define PG8_STAGE(bufoff, gbase, voff) do { _Pragma("unroll") for (int _i = 0; _i < 2; ++_i) \
        __builtin_amdgcn_global_load_lds((const unsigned*)((const char*)(gbase) + (voff)[_i]), (PG8_LAS unsigned*)(lds + (bufoff) + ldsw + _i * 8192), 16, 0, 0); } while (0)
#define PG8_LDA(dst, b, h) do { _Pragma("unroll") for (int m = 0; m < 4; ++m) _Pragma("unroll") for (int k = 0; k < 2; ++k) dst[m][k] = *(const PG8_LAS bf16x8*)(lds + PG8_SA(b, h) + aoff + m * 2048 + k * 1024); } while (0)
#define PG8_LDB(dst, b, h) do { _Pragma("unroll") for (int n = 0; n < 2; ++n) _Pragma("unroll") for (int k = 0; k < 2; ++k) dst[n][k] = *(const PG8_LAS bf16x8*)(lds + PG8_SB(b, h) + boff + n * 2048 + k * 1024); } while (0)
#define PG8_MMA(ai, bj, At, Bt) do { __builtin_amdgcn_s_setprio(1); _Pragma("unroll") for (int m = 0; m < 4; ++m) _Pragma("unroll") for (int n = 0; n < 2; ++n) _Pragma("unroll") for (int k = 0; k < 2; ++k) \
        acc[ai][bj][m][n] = __builtin_amdgcn_mfma_f32_16x16x32_bf16(Bt[n][k], At[m][k], acc[ai][bj][m][n], 0, 0, 0); __builtin_amdgcn_s_setprio(0); } while (0)
#define PG8_WAIT_V(n) asm volatile("s_waitcnt vmcnt(" #n ")" ::: "memory")
#define PG8_WAIT_L(n) asm volatile("s_waitcnt lgkmcnt(" #n ")" ::: "memory")
#define PG8_BAR __builtin_amdgcn_s_barrier()
#define PG8_SCHED __builtin_amdgcn_sched_barrier(0)
    Unit cur, nxt; int ui = 0;
    if (!S.next(0, cur)) return;
    nt = S.nkt(cur);
    f32x4 acc[2][2][4][2];
#pragma unroll
    for (int a = 0; a < 2; ++a)
#pragma unroll
        for (int b = 0; b < 2; ++b)
#pragma unroll
            for (int m = 0; m < 4; ++m)
#pragma unroll
                for (int n = 0; n < 2; ++n) acc[a][b][m][n] = (f32x4){0.f, 0.f, 0.f, 0.f};
    bf16x8 At[4][2], B0[2][2], B1[2][2];
    const char* cA = S.aptr(cur); const char* cB = S.bptr(cur);
    S.a_ready(cur);
    if constexpr (SP2) {
        PG8_STAGE(PG8_SB(0, 0), cB, voffB); PG8_STAGE(PG8_SB(0, 1), cB + hstep, voffB); PG8_STAGE(PG8_SA(0, 0), cA, voffA); PG8_STAGE(PG8_SA(0, 1), cA + hstep, voffA);
        if (wr == 1) PG8_BAR;
        PG8_WAIT_V(2); PG8_BAR;
        PG8_STAGE(PG8_SB(1, 0), cB + kstep, voffB); PG8_STAGE(PG8_SA(1, 0), cA + kstep, voffA); PG8_STAGE(PG8_SB(1, 1), cB + hstep + kstep, voffB);
        PG8_WAIT_V(6); PG8_BAR;
    } else {
        PG8_STAGE(PG8_SB(0, 0), cB, voffB); PG8_STAGE(PG8_SA(0, 0), cA, voffA); PG8_STAGE(PG8_SB(0, 1), cB + hstep, voffB); PG8_STAGE(PG8_SA(0, 1), cA + hstep, voffA);
        if (wr == 1) PG8_BAR;
        PG8_WAIT_V(4); PG8_BAR;
        PG8_STAGE(PG8_SB(1, 0), cB + kstep, voffB); PG8_STAGE(PG8_SA(1, 0), cA + kstep, voffA); PG8_STAGE(PG8_SB(1, 1), cB + hstep + kstep, voffB);
        PG8_WAIT_V(6); PG8_BAR;
    }
    for (;;) {
        const bool has_next = S.next(ui + 1, nxt);
        const char* nA = has_next ? S.aptr(nxt) : cA; const char* nB = has_next ? S.bptr(nxt) : cB;
        for (int t = 0; t < nt; t += 2) {
            const bool last = (t == nt - 2);
            const char* a1 = cA + (size_t)(t + 1) * kstep;
            const char* a2 = last ? nA : cA + (size_t)(t + 2) * kstep; const char* b2 = last ? nB : cB + (size_t)(t + 2) * kstep;
            const char* a3 = a2 + kstep; const char* b3 = b2 + kstep;
            if (last && has_next) S.a_ready(nxt);
            if constexpr (SP2) {
            PG8_LDB(B0, 0, 0); PG8_LDB(B1, 0, 1); PG8_SCHED; PG8_LDA(At, 0, 0); PG8_STAGE(PG8_SA(1, 1), a1 + hstep, voffA);
            PG8_WAIT_V(8); PG8_WAIT_L(0); PG8_BAR; PG8_MMA(0, 0, At, B0); PG8_MMA(0, 1, At, B1); PG8_BAR; PG8_SCHED;
            PG8_LDA(At, 0, 1); PG8_STAGE(PG8_SB(0, 0), b2, voffB); PG8_STAGE(PG8_SB(0, 1), b2 + hstep, voffB); PG8_STAGE(PG8_SA(0, 0), a2, voffA);
            PG8_WAIT_V(8); PG8_WAIT_L(0); PG8_BAR; PG8_MMA(1, 0, At, B0); PG8_MMA(1, 1, At, B1); PG8_BAR; PG8_SCHED;
            PG8_LDB(B0, 1, 0); PG8_LDB(B1, 1, 1); PG8_SCHED; PG8_LDA(At, 1, 0); PG8_STAGE(PG8_SA(0, 1), a2 + hstep, voffA);
            PG8_WAIT_V(8); PG8_WAIT_L(0); PG8_BAR; PG8_MMA(0, 0, At, B0); PG8_MMA(0, 1, At, B1); PG8_BAR; PG8_SCHED;
            PG8_LDA(At, 1, 1); PG8_STAGE(PG8_SB(1, 0), b3, voffB); PG8_STAGE(PG8_SB(1, 1), b3 + hstep, voffB); PG8_STAGE(PG8_SA(1, 0), a3, voffA);
            PG8_WAIT_V(8); PG8_WAIT_L(0); PG8_BAR; PG8_MMA(1, 0, At, B0); PG8_MMA(1, 1, At, B1); PG8_BAR; PG8_SCHED;
            } else {
            PG8_LDB(B0, 0, 0); PG8_SCHED; PG8_LDA(At, 0, 0); PG8_STAGE(PG8_SA(1, 1), a1 + hstep, voffA);
            PG8_WAIT_L(8); PG8_BAR; PG8_WAIT_L(0); PG8_MMA(0, 0, At, B0); PG8_BAR; PG8_SCHED;
            PG8_LDB(B1, 0, 1); PG8_STAGE(PG8_SB(0, 0), b2, voffB);
            PG8_BAR; PG8_WAIT_L(0); PG8_MMA(0, 1, At, B1); PG8_BAR;
            PG8_LDA(At, 0, 1); PG8_STAGE(PG8_SA(0, 0), a2, voffA);
            PG8_BAR; PG8_WAIT_L(0); PG8_MMA(1, 0, At, B0); PG8_BAR; PG8_SCHED;
            PG8_STAGE(PG8_SB(0, 1), b2 + hstep, voffB);
            PG8_WAIT_V(6); PG8_BAR; PG8_MMA(1, 1, At, B1); PG8_BAR;
            PG8_LDB(B0, 1, 0); PG8_SCHED; PG8_LDA(At, 1, 0); PG8_STAGE(PG8_SA(0, 1), a2 + hstep, voffA);
            PG8_WAIT_L(8); PG8_BAR; PG8_WAIT_L(0); PG8_MMA(0, 0, At, B0); PG8_BAR; PG8_SCHED;
            PG8_LDB(B1, 1, 1); PG8_STAGE(PG8_SB(1, 0), b3, voffB);
            PG8_BAR; PG8_WAIT_L(0); PG8_MMA(0, 1, At, B1); PG8_BAR;
            PG8_LDA(At, 1, 1); PG8_STAGE(PG8_SA(1, 0), a3, voffA);
            PG8_BAR; PG8_WAIT_L(0); PG8_MMA(1, 0, At, B0); PG8_BAR; PG8_SCHED;
            PG8_STAGE(PG8_SB(1, 1), b3 + hstep, voffB);
            PG8_WAIT_V(6); PG8_BAR; PG8_MMA(1, 1, At, B1); PG8_BAR;
            }
        }
        if constexpr (ALIGN_EPI) { if (wr == 0) PG8_BAR; }
        if constexpr (!Epi::AFTER_DRAIN) { E(acc, cur, wr, wc, fr, fq); S.done(cur); }
        if (!has_next) break;
#pragma unroll
        for (int a = 0; a < 2; ++a)
#pragma unroll
            for (int b = 0; b < 2; ++b)
#pragma unroll
                for (int m = 0; m < 4; ++m)
#pragma unroll
                    for (int n = 0; n < 2; ++n) acc[a][b][m][n] = (f32x4){0.f, 0.f, 0.f, 0.f};
        cur = nxt; cA = nA; cB = nB; ++ui; nt = S.nkt(cur);
        if constexpr (ALIGN_EPI) { if (wr == 1) PG8_BAR; }
    }
    PG8_WAIT_V(0);
    if constexpr (!ALIGN_EPI) { if (wr == 0) PG8_BAR; }
    PG8_BAR;
    if constexpr (Epi::AFTER_DRAIN) { E.fused(acc, cur, wr, wc, fr, fq, lds, wid, lane); S.done(cur); }
#undef PG8_SA
#undef PG8_SB
#undef PG8_STAGE
#undef PG8_LDA
#undef PG8_LDB
#undef PG8_MMA
#undef PG8_WAIT_V
#undef PG8_WAIT_L
#undef PG8_BAR
#undef PG8_SCHED
}
}
using pg8::Unit;

struct SchedG {
    const bf16_t* A; const bf16_t* Bt; int nM, nN, K, G, c;
    __device__ __forceinline__ bool next(int i, Unit& u) const { const long L = (long)i * G + c; if (L >= (long)nM * nN) return false; pg8::map_unit((int)L, nM, nN, u.pm, u.pn); u.br = 0; u.ks = -1; return true; }
    __device__ __forceinline__ const char* aptr(const Unit& u) const { return (const char*)(A + (size_t)u.pm * 256 * K); }
    __device__ __forceinline__ const char* bptr(const Unit& u) const { return (const char*)(Bt + (size_t)u.pn * 256 * K); }
    __device__ __forceinline__ int nkt(const Unit&) const { return K / 64; }
    __device__ __forceinline__ void a_ready(const Unit&) const {}
    __device__ __forceinline__ void done(const Unit&) const {}
};
struct Sched1 {
    const bf16_t *U, *WtIn, *MemN, *WtMkv; int G, c;
    __device__ __forceinline__ bool next(int i, Unit& u) const {
        const int nf = c < 1768 ? (1768 - c + G - 1) / G : 0;
        const int jsub = nf * G + c - 1768;
        const bool hassub = jsub < 256, odd = (c & 1) && hassub;
        const int k = odd ? i - 1 : i;
        const bool issub = odd ? (i == 0) : (i == nf);
        if (issub ? !hassub : (k < 0 || k >= nf)) return false;
        const bool full = !issub; const int j = full ? 0 : jsub;
        int pm_, pn_; pg8::map_unit(full ? k * G + c : 0, 34, 52, pm_, pn_);
        const int t = j >> 3;
        u.pm = full ? pm_ : (t >> 3); u.pn = full ? pn_ : (t & 7); u.br = full ? 0 : 1; u.ks = full ? -1 : (j & 7); return true;
    }
    __device__ __forceinline__ const char* aptr(const Unit& u) const { return (const char*)((u.br ? MemN : U) + (size_t)u.pm * 256 * 2048 + (u.br ? u.ks * 256 : 0)); }
    __device__ __forceinline__ const char* bptr(const Unit& u) const { return (const char*)((u.br ? WtMkv : WtIn) + (size_t)u.pn * 256 * 2048 + (u.br ? u.ks * 256 : 0)); }
    __device__ __forceinline__ int nkt(const Unit& u) const { return u.br ? 4 : 32; }
    __device__ __forceinline__ void a_ready(const Unit&) const {}
    __device__ __forceinline__ void done(const Unit&) const {}
};
struct Sched4 {
    const bf16_t *A0, *B0; int G, c;
    __device__ __forceinline__ bool next(int i, Unit& u) const {
        const int nfull = 3 * ((256 - c + G - 1) / G);
        const bool pr = i < nfull; const int tri = pr ? (i / 3) * G + c : 0; const int j = pr ? 0 : (i - nfull) * G + c;
        if (j >= 192) return false;
        int pm_, pn_; pg8::map_unit(tri, 32, 8, pm_, pn_);
        const int t = j / 12, rem = j - t * 12;
        u.pm = pr ? pm_ : 32 + (t >> 3); u.pn = pr ? pn_ : (t & 7); u.br = pr ? i % 3 : rem >> 2; u.ks = pr ? -1 : (rem & 3); return true;
    }
    __device__ __forceinline__ int nkt(const Unit& u) const { return u.ks < 0 ? 16 : 4; }
    __device__ __forceinline__ const char* aptr(const Unit& u) const { return (const char*)(A0 + (size_t)u.br * ((size_t)MT * 1024) + (size_t)u.pm * 256 * 1024 + (u.ks < 0 ? 0 : u.ks * 256)); }
    __device__ __forceinline__ const char* bptr(const Unit& u) const { return (const char*)(B0 + (size_t)u.br * 2097152 + (size_t)u.pn * 256 * 1024 + (u.ks < 0 ? 0 : u.ks * 256)); }
    __device__ __forceinline__ void a_ready(const Unit&) const {}
    __device__ __forceinline__ void done(const Unit&) const {}
};
struct SchedT {
    const bf16_t* A; const bf16_t* Bt; int K, S, G, c;
    __device__ __forceinline__ bool next(int i, Unit& u) const {
        const int L = i * G + c; const bool pr = L < 256; const int j = pr ? 0 : L - 256;
        if (j >= 16 * S) return false;
        int pm_, pn_; pg8::map_unit(pr ? L : 0, 32, 8, pm_, pn_);
        const int t = j / S;
        u.br = 0; u.pm = pr ? pm_ : 32 + (t >> 3); u.pn = pr ? pn_ : (t & 7); u.ks = pr ? -1 : j - t * S; return true;
    }
    __device__ __forceinline__ int nkt(const Unit& u) const { return u.ks < 0 ? K / 64 : (K / 64) / S; }
    __device__ __forceinline__ const char* aptr(const Unit& u) const { return (const char*)(A + (size_t)u.pm * 256 * K + (u.ks < 0 ? 0 : u.ks * ((K / 64) / S) * 64)); }
    __device__ __forceinline__ const char* bptr(const Unit& u) const { return (const char*)(Bt + (size_t)u.pn * 256 * K + (u.ks < 0 ? 0 : u.ks * ((K / 64) / S) * 64)); }
    __device__ __forceinline__ void a_ready(const Unit&) const {}
    __device__ __forceinline__ void done(const Unit&) const {}
};

struct EpiF32 {
    static constexpr bool PERM = false, AFTER_DRAIN = false;
    float* C; int ldc;
    __device__ __forceinline__ void operator()(const f32x4 (&acc)[2][2][4][2], const Unit& u, int wr, int wc, int fr, int fq) const {
        const int row0 = u.pm * 256 + wr * 64 + fr, col0 = u.pn * 256 + wc * 32 + 4 * fq;
#pragma unroll
        for (int ai = 0; ai < 2; ++ai)
#pragma unroll
            for (int m = 0; m < 4; ++m) { float* rowp = C + (size_t)(row0 + ai * 128 + m * 16) * ldc + col0;
#pragma unroll
                for (int bj = 0; bj < 2; ++bj)
#pragma unroll
                    for (int n = 0; n < 2; ++n) *(f32x4*)(rowp + bj * 128 + n * 16) = acc[ai][bj][m][n]; }
    }
};
struct EpiF32S {
    static constexpr bool PERM = true, AFTER_DRAIN = false;
    bf16_t* C; float* SL;
    __device__ __forceinline__ void operator()(const f32x4 (&acc)[2][2][4][2], const Unit& u, int wr, int wc, int fr, int fq) const {
        const int row0 = u.pm * 256 + wr * 64 + fr, col0 = u.pn * 256 + wc * 32 + 8 * fq;
        if (u.ks < 0) {
#pragma unroll
            for (int ai = 0; ai < 2; ++ai)
#pragma unroll
                for (int m = 0; m < 4; ++m)
#pragma unroll
                    for (int bj = 0; bj < 2; ++bj) { const f32x4 v0 = acc[ai][bj][m][0], v1 = acc[ai][bj][m][1];
                        u32x4 w; w.x = cvt_pk_bf16(v0[0], v0[1]); w.y = cvt_pk_bf16(v0[2], v0[3]); w.z = cvt_pk_bf16(v1[0], v1[1]); w.w = cvt_pk_bf16(v1[2], v1[3]);
                        *(u32x4*)(C + (size_t)(row0 + ai * 128 + m * 16) * 2048 + col0 + bj * 128) = w; }
        } else {
            float* base = SL + (size_t)u.ks * SLAB_ELEMS - (size_t)MP * 2048;
#pragma unroll
            for (int ai = 0; ai < 2; ++ai)
#pragma unroll
                for (int m = 0; m < 4; ++m)
#pragma unroll
                    for (int bj = 0; bj < 2; ++bj) { float* o = base + (size_t)(row0 + ai * 128 + m * 16) * 2048 + col0 + bj * 128;
                        *(f32x4*)o = acc[ai][bj][m][0]; *(f32x4*)(o + 4) = acc[ai][bj][m][1]; }
        }
    }
};
struct Epi1 {
    static constexpr bool PERM = true, AFTER_DRAIN = false;
    bf16_t* PROJ; float* MS; int skip;
    __device__ __forceinline__ void operator()(const f32x4 (&acc)[2][2][4][2], const Unit& u, int wr, int wc, int fr, int fq) const {
        if (skip) return;
        const int row0 = u.pm * 256 + wr * 64 + fr;
        if (u.br == 0) {
            if (u.pn < 8) {
                const int col = u.pn * 128 + wc * 32 + 8 * fq;
#pragma unroll
                for (int ai = 0; ai < 2; ++ai)
#pragma unroll
                    for (int m = 0; m < 4; ++m) {
                        f32x4 v0, v1;
#pragma unroll
                        for (int j = 0; j < 4; ++j) { v0[j] = acc[ai][0][m][0][j] * sigmoidf_(acc[ai][1][m][0][j]); v1[j] = acc[ai][0][m][1][j] * sigmoidf_(acc[ai][1][m][1][j]); }
                        u32x4 w; w.x = cvt_pk_bf16(v0[0], v0[1]); w.y = cvt_pk_bf16(v0[2], v0[3]); w.z = cvt_pk_bf16(v1[0], v1[1]); w.w = cvt_pk_bf16(v1[2], v1[3]);
                        __builtin_nontemporal_store(w, (u32x4*)(PROJ + (size_t)(row0 + ai * 128 + m * 16) * PW + col));
                    }
            } else {
                const int col = u.pn * 256 - 1024 + wc * 32 + 8 * fq; const bool sig = u.pn >= 28;
#pragma unroll
                for (int ai = 0; ai < 2; ++ai)
#pragma unroll
                    for (int m = 0; m < 4; ++m)
#pragma unroll
                        for (int bj = 0; bj < 2; ++bj) {
                            f32x4 v0 = acc[ai][bj][m][0], v1 = acc[ai][bj][m][1];
                            if (sig) {
#pragma unroll
                                for (int j = 0; j < 4; ++j) { v0[j] = sigmoidf_(v0[j]); v1[j] = sigmoidf_(v1[j]); } }
                            u32x4 w; w.x = cvt_pk_bf16(v0[0], v0[1]); w.y = cvt_pk_bf16(v0[2], v0[3]); w.z = cvt_pk_bf16(v1[0], v1[1]); w.w = cvt_pk_bf16(v1[2], v1[3]);
                            __builtin_nontemporal_store(w, (u32x4*)(PROJ + (size_t)(row0 + ai * 128 + m * 16) * PW + col + bj * 128));
                        }
            }
        } else {
            const int col = u.pn * 256 + wc * 32 + 8 * fq; float* ms = MS + (size_t)u.ks * MS_ELEMS;
#pragma unroll
            for (int ai = 0; ai < 2; ++ai)
#pragma unroll
                for (int m = 0; m < 4; ++m)
#pragma unroll
                    for (int bj = 0; bj < 2; ++bj) {
                        const size_t o = (size_t)(row0 + ai * 128 + m * 16) * 2048 + col + bj * 128;
                        *(f32x4*)(ms + o) = acc[ai][bj][m][0]; *(f32x4*)(ms + o + 4) = acc[ai][bj][m][1];
                    }
        }
    }
};
struct Epi4 {
    static constexpr bool PERM = true, AFTER_DRAIN = false;
    const bf16_t* PROJ; bf16_t* MERGED; const float* bpc; float* SL;
    __device__ __forceinline__ void operator()(const f32x4 (&acc)[2][2][4][2], const Unit& u, int wr, int wc, int fr, int fq) const {
        const int row0 = u.pm * 256 + wr * 64 + fr, col0 = u.pn * 256 + wc * 32 + 8 * fq;
#pragma unroll
        for (int bj = 0; bj < 2; ++bj) {
            const int col = col0 + bj * 128;
            f32x4 b0 = (f32x4){0.f, 0.f, 0.f, 0.f}, b1 = b0;
            if (u.br == 0 && u.ks <= 0) { b0 = *(const f32x4*)(bpc + col); b1 = *(const f32x4*)(bpc + col + 4); }
#pragma unroll
            for (int ai = 0; ai < 2; ++ai) {
                u32x4 g[4], pr[4];
#pragma unroll
                for (int m = 0; m < 4; ++m) { const size_t row = (size_t)(row0 + ai * 128 + m * 16);
                    g[m] = *(const u32x4*)(PROJ + row * PW + P_G + 2048 * u.br + col);
                    pr[m] = (u32x4){0u, 0u, 0u, 0u};
                    if (u.br != 0 && u.ks < 0) pr[m] = *(const u32x4*)(MERGED + row * 2048 + col); }
#pragma unroll
                for (int m = 0; m < 4; ++m) { const size_t row = (size_t)(row0 + ai * 128 + m * 16);
                    f32x4 v0 = acc[ai][bj][m][0] + b0, v1 = acc[ai][bj][m][1] + b1;
                    v0[0] *= bflo(g[m].x); v0[1] *= bfhi(g[m].x); v0[2] *= bflo(g[m].y); v0[3] *= bfhi(g[m].y);
                    v1[0] *= bflo(g[m].z); v1[1] *= bfhi(g[m].z); v1[2] *= bflo(g[m].w); v1[3] *= bfhi(g[m].w);
                    if (u.ks >= 0) { float* sp = SL + (size_t)(u.br * 4 + u.ks) * SLAB_ELEMS + (row - MP) * 2048 + col;
                        *(f32x4*)sp = v0; *(f32x4*)(sp + 4) = v1; continue; }
                    v0[0] += bflo(pr[m].x); v0[1] += bfhi(pr[m].x); v0[2] += bflo(pr[m].y); v0[3] += bfhi(pr[m].y);
                    v1[0] += bflo(pr[m].z); v1[1] += bfhi(pr[m].z); v1[2] += bflo(pr[m].w); v1[3] += bfhi(pr[m].w);
                    u32x4 w; w.x = cvt_pk_bf16(v0[0], v0[1]); w.y = cvt_pk_bf16(v0[2], v0[3]); w.z = cvt_pk_bf16(v1[0], v1[1]); w.w = cvt_pk_bf16(v1[2], v1[3]);
                    *(u32x4*)(MERGED + row * 2048 + col) = w; }
                asm volatile("" ::: "memory");
            }
        }
    }
};
struct Epi7 {
    static constexpr bool PERM = true, AFTER_DRAIN = false;
    bf16_t* HMID;
    __device__ __forceinline__ void operator()(const f32x4 (&acc)[2][2][4][2], const Unit& u, int wr, int wc, int fr, int fq) const {
        const int row0 = u.pm * 256 + wr * 64 + fr, col = u.pn * 128 + wc * 32 + 8 * fq;
#pragma unroll
        for (int ai = 0; ai < 2; ++ai)
#pragma unroll
            for (int m = 0; m < 4; ++m) {
                f32x4 v0, v1;
#pragma unroll
                for (int j = 0; j < 4; ++j) { v0[j] = siluf_(acc[ai][0][m][0][j]) * acc[ai][1][m][0][j]; v1[j] = siluf_(acc[ai][0][m][1][j]) * acc[ai][1][m][1][j]; }
                u32x4 w; w.x = cvt_pk_bf16(v0[0], v0[1]); w.y = cvt_pk_bf16(v0[2], v0[3]); w.z = cvt_pk_bf16(v1[0], v1[1]); w.w = cvt_pk_bf16(v1[2], v1[3]);
                *(u32x4*)(HMID + (size_t)(row0 + ai * 128 + m * 16) * DFF + col) = w;
            }
    }
};

__device__ __forceinline__ void tr_item(const float* __restrict__ W, int ldw, int srccol0, int k0, bf16_t* WT, int ldt, int dstrow0, LAS float* scr, int lane) {
#pragma unroll 16
    for (int i = 0; i < 64; ++i) scr[i * 65 + lane] = __builtin_nontemporal_load(W + (size_t)(k0 + i) * ldw + srccol0 + lane);
    LDS_WAIT();
    const int c = lane & 7, nn = lane >> 3;
#pragma unroll
    for (int jj = 0; jj < 8; ++jj) { const int n = nn + 8 * jj; const LAS float* s = scr + (8 * c) * 65 + n;
        u32x4 o; o.x = cvt_pk_bf16(s[0], s[65]); o.y = cvt_pk_bf16(s[130], s[195]); o.z = cvt_pk_bf16(s[260], s[325]); o.w = cvt_pk_bf16(s[390], s[455]);
        *(u32x4*)(WT + (size_t)(dstrow0 + n) * ldt + k0 + 8 * c) = o; }
    LDS_WAIT();
}
__device__ __forceinline__ void rms_row_to_bf16(const float* x, const float* g, bf16_t* o, int lane) {
    f32x4 v[8]; float ss = 0.f;
#pragma unroll
    for (int j = 0; j < 8; ++j) { v[j] = __builtin_nontemporal_load((const f32x4*)(x + 4 * lane + 256 * j)); ss += (v[j][0] * v[j][0] + v[j][1] * v[j][1]) + (v[j][2] * v[j][2] + v[j][3] * v[j][3]); }
    const float sc = rsqrtf(wave_sum(ss) * (1.f / 2048.f) + 1e-6f);
#pragma unroll
    for (int j = 0; j < 8; ++j) { const f32x4 gg = *(const f32x4*)(g + 4 * lane + 256 * j);
        u32x2 w; w.x = cvt_pk_bf16(v[j][0] * sc * gg[0], v[j][1] * sc * gg[1]); w.y = cvt_pk_bf16(v[j][2] * sc * gg[2], v[j][3] * sc * gg[3]);
        *(u32x2*)(o + 4 * lane + 256 * j) = w; }
}
__device__ __forceinline__ void phase0(KP p, LAS unsigned char* lds) {
    const int tid = ltid(), lane = tid & 63, wave = tid >> 6;
    const int gw = blockIdx.x * 8 + wave, NGW = gridDim.x * 8;
    LAS float* scr = (LAS float*)(lds + wave * 16640);
    unsigned char* ws = p->ws;
    for (int it = gw; it < 18688; it += NGW) {
        int r = it;
        if (r < 6656) { const int kb = r / 208, nb = r % 208, n0 = 64 * nb; int src;
            if (n0 < 2048) { const int tile = n0 >> 8, within = n0 & 255; src = within < 128 ? 128 * tile + within : 1024 + 128 * tile + (within - 128); }
            else if (n0 < 6144) src = n0; else src = n0 + 16;
            tr_item(p->in[9], WIN_N, src, 64 * kb, (bf16_t*)(ws + WS_WT_IN), 2048, n0, scr, lane); continue; }
        r -= 6656;
        if (r < 5632) { const int kb = r / 176, nb = r % 176, n0 = 64 * nb, tile = n0 >> 8, within = n0 & 255;
            tr_item(within < 128 ? p->in[27] : p->in[28], DFF, 128 * tile + (within & 127), 64 * kb, (bf16_t*)(ws + WS_WT_GU), 2048, n0, scr, lane); continue; }
        r -= 5632;
        if (r < 2816) { const int kb = r >> 5, nb = r & 31; tr_item(p->in[29], 2048, 64 * nb, 64 * kb, (bf16_t*)(ws + WS_WT_DN), DFF, 64 * nb, scr, lane); continue; }
        r -= 2816;
        if (r < 1024) { const int kb = r >> 5, nb = r & 31; tr_item(p->in[24], 2048, 64 * nb, 64 * kb, (bf16_t*)(ws + WS_WT_O), 2048, 64 * nb, scr, lane); continue; }
        r -= 1024;
        if (r < 1024) { const int kb = r >> 5, nb = r & 31; tr_item(p->in[22], 2048, 64 * nb, 64 * kb, (bf16_t*)(ws + WS_WT_MKV), 2048, 64 * nb, scr, lane); continue; }
        r -= 1024;
        { const int which = r >> 9, r2 = r & 511, kb = r2 >> 5, nb = r2 & 31;
          const float* W = which == 0 ? p->in[14] : (which == 1 ? p->in[20] : p->in[23]);
          bf16_t* WT = (bf16_t*)(ws + (which == 0 ? WS_WT_PC : (which == 1 ? WS_WT_PD : WS_WT_PM)));
          tr_item(W, 2048, 64 * nb, 64 * kb, WT, 1024, 64 * nb, scr, lane); }
    }
    { bf16_t* wba = (bf16_t*)(ws + WS_WT_BA); const float* win = p->in[9];
      for (int idx = blockIdx.x * 512 + tid; idx < 32768; idx += gridDim.x * 512) { const int k = idx >> 4, n = idx & 15; wba[n * 2048 + k] = f2bf(win[(size_t)k * WIN_N + 6144 + n]); } }
    for (int row = gw; row < MT + 1024; row += NGW) {
        if (row < MP) rms_row_to_bf16(p->in[0] + (size_t)row * 2048, p->in[8], (bf16_t*)(ws + WS_U) + (size_t)row * 2048, lane);
        else if (row < MT) rms_row_to_bf16(p->in[1] + (size_t)(row - MP) * 2048, p->in[8], (bf16_t*)(ws + WS_U) + (size_t)row * 2048, lane);
        else rms_row_to_bf16(p->in[2] + (size_t)(row - MT) * 2048, p->in[21], (bf16_t*)(ws + WS_MEMN) + (size_t)(row - MT) * 2048, lane);
    }
}

__device__ __forceinline__ void thin_ba(KP p) {
    const int tid = ltid(), lane = tid & 63, wave = tid >> 6, q = lane >> 4, c = lane & 15;
    const int gw = blockIdx.x * 8 + wave, NGW = gridDim.x * 8;
    const bf16_t* U = (const bf16_t*)(p->ws + WS_U); const bf16_t* WB = (const bf16_t*)(p->ws + WS_WT_BA); float* BA = (float*)(p->ws + WS_BA);
    for (int item = gw; item < 544; item += NGW) {
        const int r0 = item * 16; f32x4 acc = (f32x4){0.f, 0.f, 0.f, 0.f};
        const bf16_t* ap = U + (size_t)(r0 + c) * 2048 + 8 * q; const bf16_t* bp = WB + (size_t)c * 2048 + 8 * q;
#pragma unroll 32
        for (int s = 0; s < 64; ++s) { const bf16x8 a = *(const bf16x8*)(ap + 32 * s), b = *(const bf16x8*)(bp + 32 * s); acc = MFMA16(a, b, acc); }
#pragma unroll
        for (int r = 0; r < 4; ++r) BA[(size_t)(r0 + 4 * q + r) * 16 + c] = acc[r];
    }
}

__device__ __forceinline__ void d2_item(KP p, LAS unsigned char* lds, int item) {
    const int tid = ltid();
    const int lane = tid & 63, wave = __builtin_amdgcn_readfirstlane(tid >> 6), q = lane >> 4, cl = lane & 15;
    const int c = item & 31, h = (item >> 5) & 7, b = item >> 8;
    const int R0 = b * 2048 + c * 64;
    LAS float* R = (LAS float*)lds;
    LAS bf16_t* qb = (LAS bf16_t*)(lds + 65536);
    LAS bf16_t* kb = (LAS bf16_t*)(lds + 82944);
    LAS float* Lm = (LAS float*)(lds + 100352);
    LAS float* sm_beta = (LAS float*)(lds + 116736);
    LAS float* sm_gam = sm_beta + 64; LAS float* sm_eg = sm_beta + 128; LAS float* sm_egl = sm_beta + 192;
    LAS float* X = R;
    const bf16_t* PROJ = (const bf16_t*)(p->ws + WS_PROJ);
    unsigned char* d2 = p->ws + WS_D2 + (size_t)item * D2_BYTES;
    bf16_t* KCp = (bf16_t*)d2; bf16_t* QGp = (bf16_t*)(d2 + 16384); bf16_t* KGTp = (bf16_t*)(d2 + 32768); bf16_t* QKdp = (bf16_t*)(d2 + 49152); float* Uc = (float*)(d2 + 57344);
    unsigned rawv[3][11]; f32x2 wv4[3][4];
#pragma unroll
    for (int x = 0; x < 3; ++x) { const int ch = 1024 * x + 128 * h + 2 * lane;
#pragma unroll
        for (int j = 0; j < 4; ++j) wv4[x][j] = *(const f32x2*)(p->in[16] + j * 3072 + ch);
#pragma unroll
        for (int rr = 0; rr < 11; ++rr) { const int ti = 8 * wave + rr - 3; rawv[x][rr] = 0u;
            if (c * 64 + ti >= 0) rawv[x][rr] = __builtin_nontemporal_load((const unsigned*)(PROJ + (size_t)(R0 + ti) * PW + P_Q + ch)); } }
    __syncthreads();
    if (wave == 0) {
        const float* BA = (const float*)(p->ws + WS_BA) + (size_t)(R0 + lane) * 16;
        const float braw = BA[h], araw = BA[8 + h];
        const float beta = sigmoidf_(braw);
        const float xx = araw + p->in[18][h];
        const float sp = xx > 20.f ? xx : log1pf(expf(xx));
        const float g = -expf(p->in[17][h]) * sp;
        float gam = g;
#pragma unroll
        for (int o = 1; o < 64; o <<= 1) { const float t = __shfl_up(gam, o); if (lane >= o) gam += t; }
        const float gl = __shfl(gam, 63);
        sm_beta[lane] = beta; sm_gam[lane] = gam; sm_eg[lane] = expf(gam); sm_egl[lane] = expf(gl - gam);
        if (lane == 63) ((float*)(p->ws + WS_GL))[item] = expf(gam);
    }
    __syncthreads();
    _Pragma("unroll 1") for (int rq_ = 0; rq_ <= ((p->dup >> 22) & 1); ++rq_) {
        const int dp = lane, tg = wave;
#pragma unroll
        for (int x = 0; x < 3; ++x) {
            const int ch = 1024 * x + 128 * h + 2 * dp;
            f32x2 w[4];
#pragma unroll
            for (int j = 0; j < 4; ++j) w[j] = wv4[x][j];
            float r0[11], r1[11];
#pragma unroll
            for (int rr = 0; rr < 11; ++rr) { r0[rr] = bflo(rawv[x][rr]); r1[rr] = bfhi(rawv[x][rr]); }
            if (c == 31 && tg == 7) {
                float* o = p->out + O_DCP + (size_t)b * 3 * 3072 + ch;
#pragma unroll
                for (int k = 0; k < 3; ++k) *(f32x2*)(o + k * 3072) = (f32x2){r0[8 + k], r1[8 + k]};
            }
            float y0[8], y1[8];
#pragma unroll
            for (int ii = 0; ii < 8; ++ii) { float a0 = 0.f, a1 = 0.f;
#pragma unroll
                for (int j = 0; j < 4; ++j) { a0 += w[j][0] * r0[ii + j]; a1 += w[j][1] * r1[ii + j]; }
                y0[ii] = siluf_(a0); y1[ii] = siluf_(a1); }
            if (x < 2) {
#pragma unroll
                for (int ii = 0; ii < 8; ++ii) { const float ss = wave_sum(y0[ii] * y0[ii] + y1[ii] * y1[ii]);
                    const float sc = rsqrtf(ss + 1e-6f) * (x == 0 ? 0.08838834764831845f : 1.f); y0[ii] *= sc; y1[ii] *= sc; }
            }
            if (x == 0) {
                const int dk = 2 * dp, pos = (dk & ~31) + perm_pos(dk & 31);
#pragma unroll
                for (int ii = 0; ii < 8; ++ii) { const int i = 8 * tg + ii; const float e = sm_eg[i];
                    *(LAS unsigned*)(qb + i * 136 + 2 * dp) = cvt_pk_bf16(y0[ii], y1[ii]);
                    *(unsigned*)(QGp + i * 128 + pos) = cvt_pk_bf16(y0[ii] * e, y1[ii] * e); }
            } else if (x == 1) {
                float e[8];
#pragma unroll
                for (int ii = 0; ii < 8; ++ii) { const int i = 8 * tg + ii; e[ii] = sm_egl[i]; const float rs = sm_beta[i] * sm_eg[i];
                    *(LAS f32x2*)(R + i * 256 + 128 + 2 * dp) = (f32x2){y0[ii] * rs, y1[ii] * rs};
                    *(LAS unsigned*)(kb + i * 136 + 2 * dp) = cvt_pk_bf16(y0[ii], y1[ii]); }
                const int s = tg >> 2, pbase = (2 * (tg & 1)) * 8 + ((tg & 3) >> 1) * 4;
                { u32x2 lo, hi;
                  lo.x = cvt_pk_bf16(y0[0] * e[0], y0[1] * e[1]); lo.y = cvt_pk_bf16(y0[2] * e[2], y0[3] * e[3]);
                  hi.x = cvt_pk_bf16(y0[4] * e[4], y0[5] * e[5]); hi.y = cvt_pk_bf16(y0[6] * e[6], y0[7] * e[7]);
                  bf16_t* dst = KGTp + (2 * dp) * 64 + 32 * s + pbase; *(u32x2*)dst = lo; *(u32x2*)(dst + 8) = hi;
                  lo.x = cvt_pk_bf16(y1[0] * e[0], y1[1] * e[1]); lo.y = cvt_pk_bf16(y1[2] * e[2], y1[3] * e[3]);
                  hi.x = cvt_pk_bf16(y1[4] * e[4], y1[5] * e[5]); hi.y = cvt_pk_bf16(y1[6] * e[6], y1[7] * e[7]);
                  dst += 64; *(u32x2*)dst = lo; *(u32x2*)(dst + 8) = hi; }
            } else {
#pragma unroll
                for (int ii = 0; ii < 8; ++ii) { const int i = 8 * tg + ii; const float rs = sm_beta[i]; *(LAS f32x2*)(R + i * 256 + 2 * dp) = (f32x2){y0[ii] * rs, y1[ii] * rs}; }
            }
        }
    }
    __syncthreads();
    _Pragma("unroll 1") for (int rq_ = 0; rq_ <= ((p->dup >> 23) & 1); ++rq_) {
        const int mt = wave >> 1, nt0 = 2 * (wave & 1);
#pragma unroll
        for (int tt = 0; tt < 2; ++tt) {
            const int nt = nt0 + tt;
            f32x4 aK = (f32x4){0.f, 0.f, 0.f, 0.f}, aQ = aK;
            if (nt <= mt) {
#pragma unroll
                for (int s = 0; s < 4; ++s) {
                    const bf16x8 ak = *(const LAS bf16x8*)(kb + (16 * mt + cl) * 136 + 32 * s + 8 * q);
                    const bf16x8 aq = *(const LAS bf16x8*)(qb + (16 * mt + cl) * 136 + 32 * s + 8 * q);
                    const bf16x8 bk = *(const LAS bf16x8*)(kb + (16 * nt + cl) * 136 + 32 * s + 8 * q);
                    aK = MFMA16(ak, bk, aK); aQ = MFMA16(aq, bk, aQ);
                }
            }
            const int j = 16 * nt + cl; const float gj = sm_gam[j];
            const int pj = 32 * (nt >> 1) + ((cl >> 2) << 3) + ((nt & 1) << 2) + (cl & 3);
#pragma unroll
            for (int r = 0; r < 4; ++r) { const int i = 16 * mt + 4 * q + r;
                const float d = (j <= i) ? expf(sm_gam[i] - gj) : 0.f;
                Lm[j * 64 + i] = (j < i) ? aK[r] * sm_beta[i] * d : 0.f;
                QKdp[i * 64 + pj] = f2bf(aQ[r] * d); }
        }
    }
    __syncthreads();
    LAS float* Tt = (LAS float*)(lds + 117760);
    if (tid < 64) {
        const int Bq = tid >> 4, cq = tid & 15;
        float t[16];
#pragma unroll
        for (int i = 0; i < 16; ++i) t[i] = (i == cq) ? 1.f : 0.f;
#pragma unroll
        for (int j = 0; j < 15; ++j) { const LAS float* lc = Lm + (16 * Bq + j) * 64 + 16 * Bq;
#pragma unroll
            for (int i4 = (j + 1) / 4; i4 < 4; ++i4) { const f32x4 l4 = *(const LAS f32x4*)(lc + 4 * i4);
#pragma unroll
                for (int e = 0; e < 4; ++e) if (4 * i4 + e > j) t[4 * i4 + e] -= l4[e] * t[j]; } }
#pragma unroll
        for (int i4 = 0; i4 < 4; ++i4) *(LAS f32x4*)(Tt + Bq * 256 + cq * 16 + 4 * i4) = (f32x4){t[4 * i4], t[4 * i4 + 1], t[4 * i4 + 2], t[4 * i4 + 3]};
    } else if (tid >= 256) {
        const float* MS = (const float*)(p->ws + WS_MS);
        bf16_t* MKB = (bf16_t*)(p->ws + WS_MKB); bf16_t* MVB = (bf16_t*)(p->ws + WS_MVB);
#pragma unroll
        for (int k2 = 0; k2 < 2; ++k2) { const int idx = item * 512 + (tid - 256) + 256 * k2; const int row = idx >> 9, col = (idx & 511) * 4;
            f32x4 a = *(const f32x4*)(MS + (size_t)idx * 4);
#pragma unroll
            for (int k = 1; k < 8; ++k) a += *(const f32x4*)(MS + k * MS_ELEMS + (size_t)idx * 4);
            const bool isv = col >= 1024; const size_t o = (size_t)row * 1024 + (col & 1023);
            *(f32x4*)(p->out + (isv ? O_MV : O_MK) + o) = a;
            u32x2 w; w.x = cvt_pk_bf16(a[0], a[1]); w.y = cvt_pk_bf16(a[2], a[3]);
            *(u32x2*)((isv ? MVB : MKB) + o) = w; }
    }
    __syncthreads();
    {
        const int col0 = 32 * wave + cl;
#pragma unroll 1
        for (int B = 0; B < 4; ++B) {
            LAS float* rb = R + (16 * B + 4 * q) * 256 + col0;
            f32x4 a0, a1;
#pragma unroll
            for (int r = 0; r < 4; ++r) { a0[r] = rb[r * 256]; a1[r] = rb[r * 256 + 16]; }
            const LAS float* lp = Lm + q * 64 + 16 * B + cl; const LAS float* xp = R + q * 256 + col0;
#pragma unroll 4
            for (int s4 = 0; s4 < 4 * B; ++s4) { const float av = -lp[s4 * 256], b0 = xp[s4 * 1024], b1 = xp[s4 * 1024 + 16];
                a0 = __builtin_amdgcn_mfma_f32_16x16x4f32(av, b0, a0, 0, 0, 0); a1 = __builtin_amdgcn_mfma_f32_16x16x4f32(av, b1, a1, 0, 0, 0); }
#pragma unroll
            for (int r = 0; r < 4; ++r) { rb[r * 256] = a0[r]; rb[r * 256 + 16] = a1[r]; }
            LDS_WAIT();
            f32x4 x0 = (f32x4){0.f, 0.f, 0.f, 0.f}, x1 = x0;
            const LAS float* tp = Tt + B * 256 + q * 16 + cl; const LAS float* yp = R + (16 * B + q) * 256 + col0;
#pragma unroll
            for (int s4 = 0; s4 < 4; ++s4) { const float av = tp[s4 * 64], b0 = yp[s4 * 1024], b1 = yp[s4 * 1024 + 16];
                x0 = __builtin_amdgcn_mfma_f32_16x16x4f32(av, b0, x0, 0, 0, 0); x1 = __builtin_amdgcn_mfma_f32_16x16x4f32(av, b1, x1, 0, 0, 0); }
            LDS_WAIT();
#pragma unroll
            for (int r = 0; r < 4; ++r) { rb[r * 256] = x0[r]; rb[r * 256 + 16] = x1[r]; }
            LDS_WAIT();
        }
    }
    __syncthreads();
    _Pragma("unroll 1") for (int rq_ = 0; rq_ <= ((p->dup >> 24) & 1); ++rq_) {
#pragma unroll
    for (int k = 0; k < 2; ++k) { const int id = tid + 512 * k, i = id >> 4, p0 = (id & 15) * 8, s = p0 >> 5, q_ = (p0 & 31) >> 3;
        float v[8];
#pragma unroll
        for (int j = 0; j < 8; ++j) v[j] = X[i * 256 + 128 + 32 * s + 16 * (j >> 2) + 4 * q_ + (j & 3)];
        u32x4 w; w.x = cvt_pk_bf16(v[0], v[1]); w.y = cvt_pk_bf16(v[2], v[3]); w.z = cvt_pk_bf16(v[4], v[5]); w.w = cvt_pk_bf16(v[6], v[7]);
        *(u32x4*)(KCp + i * 128 + p0) = w; }
#pragma unroll
    for (int k = 0; k < 16; ++k) { const int idx = tid + 512 * k, w_ = idx >> 10, mt = (idx >> 8) & 3, r = (idx >> 6) & 3, ln = idx & 63;
        Uc[idx] = X[(16 * mt + 4 * (ln >> 4) + r) * 256 + 16 * w_ + (ln & 15)]; }
    }
}

template <int NT, bool SAMPLE>
__device__ __forceinline__ void conv_item(KP p, LAS unsigned char* lds, int idx) {
    const int tid = ltid();
    const int lane = tid & 63, wave = __builtin_amdgcn_readfirstlane(tid >> 6), ch = 2 * tid;
    const bf16_t* PROJ = (const bf16_t*)(p->ws + WS_PROJ);
    bf16_t* CB = (bf16_t*)(p->ws + WS_CB);
    LAS float* T = (LAS float*)lds;
    const int b = SAMPLE ? idx : (idx >> 6), t0 = SAMPLE ? 0 : (idx & 63) * 32;
    float w0[31], w1[31], P0[31], P1[31];
#pragma unroll
    for (int j = 0; j < 31; ++j) { const f32x2 wv = *(const f32x2*)(p->in[10] + j * 1024 + ch); w0[j] = wv[0]; w1[j] = wv[1]; P0[j] = 0.f; P1[j] = 0.f; }
    const f32x2 bd = *(const f32x2*)(p->in[11] + ch);
    __syncthreads();
#define CONV_STEP(x0_, x1_, r_) do { const float cx0 = (x0_), cx1 = (x1_); const int cr = (r_); \
        const float e0 = fmaf(w0[30], cx0, P0[30]), e1 = fmaf(w1[30], cx1, P1[30]); \
        _Pragma("unroll") for (int j = 30; j >= 1; --j) { P0[j] = fmaf(w0[j - 1], cx0, P0[j - 1]); P1[j] = fmaf(w1[j - 1], cx1, P1[j - 1]); asm volatile("" : "+v"(P0[j]), "+v"(P1[j])); } \
        P0[0] = 0.f; P1[0] = 0.f; \
        if (cr >= 30 && cr < NT + 30) *(LAS f32x2*)(T + (cr - 30) * 1024 + ch) = (f32x2){e0 + bd[0], e1 + bd[1]}; } while (0)
    if (SAMPLE) {
#pragma unroll 1
        for (int rb = 0; rb < 30; rb += 10) {
            f32x2 xr[10];
#pragma unroll
            for (int k = 0; k < 10; ++k) xr[k] = __builtin_nontemporal_load((const f32x2*)(p->in[5] + ((size_t)b * 30 + rb + k) * 1024 + ch));
#pragma unroll
            for (int k = 0; k < 10; ++k) { const int r = rb + k;
                if (r >= 4) *(f32x2*)(p->out + O_CS + ((size_t)b * 30 + (r - 4)) * 1024 + ch) = xr[k];
                CONV_STEP(xr[k][0], xr[k][1], r); }
        }
        unsigned xn[4];
#pragma unroll
        for (int k = 0; k < 4; ++k) xn[k] = *(const unsigned*)(PROJ + (size_t)(MP + 4 * b + k) * PW + P_GLU + ch);
#pragma unroll
        for (int k = 0; k < 4; ++k) { const float x0 = bflo(xn[k]), x1 = bfhi(xn[k]);
            *(f32x2*)(p->out + O_CS + ((size_t)b * 30 + 26 + k) * 1024 + ch) = (f32x2){x0, x1};
            CONV_STEP(x0, x1, 30 + k); }
    } else {
#pragma unroll 1
        for (int rb = 0; rb < 64; rb += 8) {
            unsigned xr[8];
#pragma unroll
            for (int k = 0; k < 8; ++k) { const int t = t0 - 30 + rb + k; xr[k] = 0u;
                if (t >= 0 && rb + k < 62) xr[k] = __builtin_nontemporal_load((const unsigned*)(PROJ + (size_t)(b * 2048 + t) * PW + P_GLU + ch)); }
#pragma unroll
            for (int k = 0; k < 8; ++k) { const int r = rb + k, t = t0 - 30 + r; const float x0 = bflo(xr[k]), x1 = bfhi(xr[k]);
                if (t >= 2018 && r < 62) *(f32x2*)(p->out + O_CP + ((size_t)b * 30 + (t - 2018)) * 1024 + ch) = (f32x2){x0, x1};
                CONV_STEP(x0, x1, r); }
        }
    }
#undef CONV_STEP
    __syncthreads();
    for (int tt = wave; tt < NT; tt += 8) {
        f32x4 v[4]; float s1 = 0.f, s2 = 0.f;
#pragma unroll
        for (int k = 0; k < 4; ++k) { v[k] = *(const LAS f32x4*)(T + tt * 1024 + 4 * lane + 256 * k);
            s1 += (v[k][0] + v[k][1]) + (v[k][2] + v[k][3]); s2 += (v[k][0] * v[k][0] + v[k][1] * v[k][1]) + (v[k][2] * v[k][2] + v[k][3] * v[k][3]); }
        s1 = wave_sum(s1); s2 = wave_sum(s2);
        const float mu = s1 * (1.f / 1024.f), var = s2 * (1.f / 1024.f) - mu * mu, rs = rsqrtf(fmaxf(var, 0.f) + 1e-5f);
        const size_t row = SAMPLE ? (size_t)(MP + 4 * b + tt) : (size_t)(b * 2048 + t0 + tt);
#pragma unroll
        for (int k = 0; k < 4; ++k) { const int c4 = 4 * lane + 256 * k;
            const f32x4 lg = *(const f32x4*)(p->in[12] + c4), lb = *(const f32x4*)(p->in[13] + c4);
            f32x4 y = (v[k] - mu) * rs * lg + lb;
            u32x2 wv; wv.x = cvt_pk_bf16(siluf_(y[0]), siluf_(y[1])); wv.y = cvt_pk_bf16(siluf_(y[2]), siluf_(y[3]));
            *(u32x2*)(CB + row * 1024 + c4) = wv; }
    }
}

__device__ __forceinline__ void sattn_item(KP p, LAS unsigned char* lds, int item) {
    const int tid = ltid();
    const int lane = tid & 63, wave = __builtin_amdgcn_readfirstlane(tid >> 6), q = lane >> 4, c = lane & 15;
    const int b = item >> 2, h = item & 3;
    const bf16_t* PROJ = (const bf16_t*)(p->ws + WS_PROJ);
    LAS float* sc = (LAS float*)lds;
    LAS float* part = (LAS float*)(lds + 4096);
    const float* vp = p->in[4] + ((size_t)(b * 256 + 32 * wave) * 4 + h) * 256 + 4 * lane;
    f32x4 vpre[16];
#pragma unroll
    for (int mm = 0; mm < 16; ++mm) vpre[mm] = __builtin_nontemporal_load((const f32x4*)(vp + (size_t)mm * 1024));
    __syncthreads();
    {
        bf16x8 qf[8];
#pragma unroll
        for (int s = 0; s < 8; ++s) { u32x4 v = (u32x4){0u, 0u, 0u, 0u};
            if (c < 4) v = *(const u32x4*)(PROJ + (size_t)(MP + 4 * b + c) * PW + P_XQ + 256 * h + 32 * s + 8 * q);
            qf[s] = __builtin_bit_cast(bf16x8, v); }
#pragma unroll
        for (int tt = 0; tt < 2; ++tt) { const int kt = 2 * wave + tt;
            const float* kp = p->in[3] + ((size_t)(b * 256 + 16 * kt + c) * 4 + h) * 256 + 8 * q;
            f32x4 acc = (f32x4){0.f, 0.f, 0.f, 0.f};
#pragma unroll
            for (int s = 0; s < 8; ++s) { const f32x4 k0 = __builtin_nontemporal_load((const f32x4*)(kp + 32 * s)), k1 = __builtin_nontemporal_load((const f32x4*)(kp + 32 * s + 4)); acc = MFMA16(pack8(k0, k1), qf[s], acc); }
            if (c < 4) {
#pragma unroll
                for (int r = 0; r < 4; ++r) sc[c * 256 + 16 * kt + 4 * q + r] = acc[r] * 0.0625f; }
        }
    }
    __syncthreads();
    if (wave < 4) { f32x4 v = *(const LAS f32x4*)(sc + wave * 256 + 4 * lane);
        const float m = wave_max(fmaxf(fmaxf(v[0], v[1]), fmaxf(v[2], v[3])));
        v[0] = __expf(v[0] - m); v[1] = __expf(v[1] - m); v[2] = __expf(v[2] - m); v[3] = __expf(v[3] - m);
        const float inv = 1.f / wave_sum((v[0] + v[1]) + (v[2] + v[3]));
        *(LAS f32x4*)(sc + wave * 256 + 4 * lane) = v * inv; }
    __syncthreads();
    {
        f32x4 acc[4];
#pragma unroll
        for (int t = 0; t < 4; ++t) acc[t] = (f32x4){0.f, 0.f, 0.f, 0.f};
        f32x4 vlate[16];
#pragma unroll
        for (int mm = 0; mm < 16; ++mm) vlate[mm] = __builtin_nontemporal_load((const f32x4*)(vp + (size_t)(16 + mm) * 1024));
#pragma unroll
        for (int mm = 0; mm < 16; ++mm) {
#pragma unroll
            for (int t = 0; t < 4; ++t) acc[t] += vpre[mm] * sc[t * 256 + 32 * wave + mm]; }
#pragma unroll
        for (int mm = 0; mm < 16; ++mm) {
#pragma unroll
            for (int t = 0; t < 4; ++t) acc[t] += vlate[mm] * sc[t * 256 + 32 * wave + 16 + mm]; }
#pragma unroll
        for (int t = 0; t < 4; ++t) *(LAS f32x4*)(part + (wave * 4 + t) * 256 + 4 * lane) = acc[t];
    }
    __syncthreads();
    { const int t = tid >> 7, d = (tid & 127) * 2; float s0 = 0.f, s1 = 0.f;
#pragma unroll
      for (int w = 0; w < 8; ++w) { const f32x2 v = *(const LAS f32x2*)(part + (w * 4 + t) * 256 + d); s0 += v[0]; s1 += v[1]; }
      *(unsigned*)((bf16_t*)(p->ws + WS_XO) + (size_t)(MP + 4 * b + t) * 1024 + 256 * h + d) = cvt_pk_bf16(s0, s1); }
}

__device__ __forceinline__ void mkv_reduce(KP p, int bx, int G) {
    const int tid = ltid();
    const float* MS = (const float*)(p->ws + WS_MS);
    bf16_t* MKB = (bf16_t*)(p->ws + WS_MKB); bf16_t* MVB = (bf16_t*)(p->ws + WS_MVB);
    for (int idx = bx * 512 + tid; idx < 1024 * 512; idx += G * 512) { const int row = idx >> 9, col = (idx & 511) * 4;
        f32x4 a = *(const f32x4*)(MS + (size_t)idx * 4);
#pragma unroll
        for (int k = 1; k < 8; ++k) a += *(const f32x4*)(MS + k * MS_ELEMS + (size_t)idx * 4);
        const bool isv = col >= 1024; const size_t o = (size_t)row * 1024 + (col & 1023);
        *(f32x4*)(p->out + (isv ? O_MV : O_MK) + o) = a;
        u32x2 w; w.x = cvt_pk_bf16(a[0], a[1]); w.y = cvt_pk_bf16(a[2], a[3]);
        *(u32x2*)((isv ? MVB : MKB) + o) = w; }
}

__device__ __forceinline__ void scan_item(KP p, LAS unsigned char* lds, int bh) {
    const int tid = ltid();
    const int lane = tid & 63, w = __builtin_amdgcn_readfirstlane(tid >> 6), q = lane >> 4, c = lane & 15;
    const float* GL = (const float*)(p->ws + WS_GL) + bh * 32;
    const unsigned char* d2 = p->ws + WS_D2 + (size_t)bh * 32 * D2_BYTES;
    unsigned char* sw = p->ws + WS_SW + ((size_t)bh * 32 * 8 + w) * 6144 + lane * 16;
    constexpr int BUF = 35840, O_KC = 0, O_KGT = 17408;
    f32x4 St[8];
#pragma unroll
    for (int i = 0; i < 8; ++i) St[i] = (f32x4){0.f, 0.f, 0.f, 0.f};
    u32x4 stg[4]; f32x4 u[4];
    __syncthreads();
#define SCAN_LOAD(chunkp) do { _Pragma("unroll") for (int k = 0; k < 2; ++k) { stg[k] = *(const u32x4*)((chunkp) + (size_t)(tid + 512 * k) * 16); stg[2 + k] = *(const u32x4*)((chunkp) + 32768 + (size_t)(tid + 512 * k) * 16); } } while (0)
#define SCAN_WRITE(bufp) do { \
        _Pragma("unroll") for (int k = 0; k < 2; ++k) { const int id = tid + 512 * k; *(LAS u32x4*)((bufp) + O_KC + (id >> 4) * 272 + (id & 15) * 16) = stg[k]; \
            *(LAS u32x4*)((bufp) + O_KGT + (id >> 3) * 144 + (id & 7) * 16) = stg[2 + k]; } } while (0)
#define SCAN_LOADU(dst, chunkp) do { const float* Uc_ = (const float*)((chunkp) + 57344); \
        _Pragma("unroll") for (int mt = 0; mt < 4; ++mt) _Pragma("unroll") for (int r = 0; r < 4; ++r) dst[mt][r] = Uc_[((w * 4 + mt) * 4 + r) * 64 + lane]; } while (0)
    f32x4 un[4]; u32x4 stg2[4];
    SCAN_LOAD(d2); SCAN_LOADU(u, d2);
    SCAN_WRITE(lds);
    SCAN_LOAD(d2 + D2_BYTES); SCAN_LOADU(un, d2 + D2_BYTES);
    const float glv = GL[lane & 31];
    __syncthreads();
#pragma unroll 1
    for (int step = 0; step < 32; ++step) {
        LAS unsigned char* cur = lds + (step & 1) * BUF; LAS unsigned char* nxt = lds + ((step + 1) & 1) * BUF;
        const bool more = step + 1 < 32, more2 = step + 2 < 32;
        const unsigned char* c2 = d2 + (size_t)(step + 2) * D2_BYTES;
        f32x4 u2[4];
        if (more2) {
#pragma unroll
            for (int k = 0; k < 2; ++k) { stg2[k] = *(const u32x4*)(c2 + (size_t)(tid + 512 * k) * 16); stg2[2 + k] = *(const u32x4*)(c2 + 32768 + (size_t)(tid + 512 * k) * 16); }
            SCAN_LOADU(u2, c2); }
        const float gl = __uint_as_float((unsigned)__builtin_amdgcn_readlane((int)__float_as_uint(glv), step));
        unsigned char* swp = sw + (size_t)step * (8 * 6144);
        bf16x8 Sb[4];
#pragma unroll
        for (int s = 0; s < 4; ++s) { Sb[s] = pack8(St[2 * s], St[2 * s + 1]); *(bf16x8*)(swp + s * 1024) = Sb[s]; }
        f32x4 W[4];
#pragma unroll
        for (int mt = 0; mt < 4; ++mt) { f32x4 a = (f32x4){0.f, 0.f, 0.f, 0.f};
#pragma unroll
            for (int s = 0; s < 4; ++s) a = MFMA16(*(const LAS bf16x8*)(cur + O_KC + (16 * mt + c) * 272 + (32 * s + 8 * q) * 2), Sb[s], a);
            W[mt] = u[mt] - a; }
        bf16x8 Wb[2];
#pragma unroll
        for (int s = 0; s < 2; ++s) { Wb[s] = pack8(W[2 * s], W[2 * s + 1]); *(bf16x8*)(swp + 4096 + s * 1024) = Wb[s]; }
#pragma unroll
        for (int i = 0; i < 8; ++i) { f32x4 a = St[i] * gl;
#pragma unroll
            for (int s = 0; s < 2; ++s) a = MFMA16(*(const LAS bf16x8*)(cur + O_KGT + (16 * i + c) * 144 + (32 * s + 8 * q) * 2), Wb[s], a);
            St[i] = a; }
        if (more) SCAN_WRITE(nxt);
        asm volatile("s_waitcnt lgkmcnt(0)" ::: "memory"); __builtin_amdgcn_s_barrier(); asm volatile("" ::: "memory");
#pragma unroll
        for (int mt = 0; mt < 4; ++mt) { u[mt] = un[mt]; if (more2) un[mt] = u2[mt]; }
        if (more2) {
#pragma unroll
            for (int k = 0; k < 4; ++k) stg[k] = stg2[k]; }
    }
#undef SCAN_LOADU
#undef SCAN_LOAD
#undef SCAN_WRITE
    float* so = p->out + O_DSP + (size_t)bh * 16384;
#pragma unroll
    for (int i = 0; i < 8; ++i)
#pragma unroll
        for (int r = 0; r < 4; ++r) so[(16 * i + 4 * q + r) * 128 + 16 * w + c] = St[i][r];
}

__device__ __forceinline__ void o_wave_item(KP p, int witem) {
    const int lane = ltid() & 63, q = lane >> 4, c = lane & 15;
    const int mh = witem & 1, item = witem >> 1, step = item & 31, bh = item >> 5, h = bh & 7, b = bh >> 3;
    const bf16_t* PROJ = (const bf16_t*)(p->ws + WS_PROJ);
    bf16_t* OD = (bf16_t*)(p->ws + WS_OD);
    const unsigned char* d2 = p->ws + WS_D2 + (size_t)item * D2_BYTES;
    const bf16_t* QGp = (const bf16_t*)(d2 + 16384); const bf16_t* QKp = (const bf16_t*)(d2 + 49152);
    const unsigned char* swp = p->ws + WS_SW + (size_t)item * 8 * 6144 + lane * 16;
    const size_t rowb = (size_t)b * 2048 + 64 * step + 32 * mh;
    bf16x8 ag[2][4], ak[2][2];
#pragma unroll
    for (int m = 0; m < 2; ++m) {
#pragma unroll
        for (int s = 0; s < 4; ++s) ag[m][s] = *(const bf16x8*)(QGp + (32 * mh + 16 * m + c) * 128 + 32 * s + 8 * q);
#pragma unroll
        for (int s = 0; s < 2; ++s) ak[m][s] = *(const bf16x8*)(QKp + (32 * mh + 16 * m + c) * 64 + 32 * s + 8 * q); }
    f32x4 O[2][8]; float ss[2][4];
    bf16_t zr[8][2][4];
#pragma unroll
    for (int nt = 0; nt < 8; ++nt)
#pragma unroll
        for (int m = 0; m < 2; ++m)
#pragma unroll
            for (int r = 0; r < 4; ++r) zr[nt][m][r] = PROJ[(rowb + 16 * m + 4 * q + r) * PW + P_Z + 128 * h + 16 * nt + c];
#pragma unroll
    for (int m = 0; m < 2; ++m)
#pragma unroll
        for (int r = 0; r < 4; ++r) ss[m][r] = 0.f;
#pragma unroll
    for (int nt = 0; nt < 8; ++nt) {
        bf16x8 Sb[4], Wb[2];
#pragma unroll
        for (int s = 0; s < 4; ++s) Sb[s] = *(const bf16x8*)(swp + nt * 6144 + s * 1024);
#pragma unroll
        for (int s = 0; s < 2; ++s) Wb[s] = *(const bf16x8*)(swp + nt * 6144 + 4096 + s * 1024);
#pragma unroll
        for (int m = 0; m < 2; ++m) { f32x4 o = (f32x4){0.f, 0.f, 0.f, 0.f};
#pragma unroll
            for (int s = 0; s < 4; ++s) o = MFMA16(ag[m][s], Sb[s], o);
#pragma unroll
            for (int s = 0; s < 2; ++s) o = MFMA16(ak[m][s], Wb[s], o);
            O[m][nt] = o;
#pragma unroll
            for (int r = 0; r < 4; ++r) ss[m][r] += o[r] * o[r]; }
    }
#pragma unroll
    for (int m = 0; m < 2; ++m)
#pragma unroll
        for (int r = 0; r < 4; ++r) { float t = ss[m][r]; t += __shfl_xor(t, 1); t += __shfl_xor(t, 2); t += __shfl_xor(t, 4); t += __shfl_xor(t, 8);
            ss[m][r] = rsqrtf(t * (1.f / 128.f) + 1e-6f); }
#pragma unroll
    for (int nt = 0; nt < 8; ++nt) { const float gdn = p->in[19][16 * nt + c];
#pragma unroll
        for (int m = 0; m < 2; ++m)
#pragma unroll
            for (int r = 0; r < 4; ++r) { const size_t row = rowb + 16 * m + 4 * q + r;
                const float z = bf2f(zr[nt][m][r]);
                OD[row * 1024 + 128 * h + 16 * nt + c] = f2bf(O[m][nt][r] * ss[m][r] * gdn * siluf_(z)); } }
}

__device__ __forceinline__ void sdelta_pair(KP p, LAS unsigned char* lds0, int item0, int item1) {
    const int tid = ltid();
    const int sub = __builtin_amdgcn_readfirstlane(tid >> 8), t8 = tid & 255, lane = tid & 63, wv = __builtin_amdgcn_readfirstlane((tid >> 6) & 3);
    const int item = sub ? item1 : item0;
    const int b = item >> 3, h = item & 7;
    const bf16_t* PROJ = (const bf16_t*)(p->ws + WS_PROJ);
    LAS unsigned char* lds = lds0 + sub * 32768;
    LAS float* qkv = (LAS float*)lds;
    LAS float* redK = (LAS float*)(lds + 8192);
    LAS float* redO = (LAS float*)(lds + 16384);
    LAS float* sm = (LAS float*)(lds + 24576);
    const int dv = t8 & 127, dg = t8 >> 7;
    const float* s0 = p->in[7] + ((size_t)(b * 8 + h) * 128 + 64 * dg) * 128 + dv;
    float S[64];
#pragma unroll
    for (int i = 0; i < 64; ++i) S[i] = __builtin_nontemporal_load(s0 + i * 128);
    __syncthreads();
    {
        float ev[6][4], wv[6][4];
#pragma unroll
        for (int k = 0; k < 6; ++k) { const int idx = t8 + 256 * k, x = idx >> 9, t = (idx >> 7) & 3, d = idx & 127;
            const int ch = 1024 * x + 128 * h + d;
#pragma unroll
            for (int j = 0; j < 4; ++j) { const int er = t + j;
                ev[k][j] = er < 3 ? p->in[6][((size_t)b * 3 + er) * 3072 + ch] : bf2f(PROJ[(size_t)(MP + 4 * b + er - 3) * PW + P_Q + ch]);
                wv[k][j] = p->in[16][j * 3072 + ch]; } }
#pragma unroll
        for (int k = 0; k < 6; ++k) { const int idx = t8 + 256 * k, x = idx >> 9, t = (idx >> 7) & 3, d = idx & 127;
            const int ch = 1024 * x + 128 * h + d;
            float y = 0.f;
#pragma unroll
            for (int j = 0; j < 4; ++j) y += wv[k][j] * ev[k][j];
            qkv[(x * 4 + t) * 128 + d] = siluf_(y);
            if (t == 3) {
#pragma unroll
                for (int kk = 0; kk < 3; ++kk) p->out[O_DCS + ((size_t)b * 3 + kk) * 3072 + ch] = ev[k][1 + kk]; }
        }
        if (t8 < 4) { const float* BA = (const float*)(p->ws + WS_BA) + (size_t)(MP + 4 * b + t8) * 16;
            const float xx = BA[8 + h] + p->in[18][h]; const float sp = xx > 20.f ? xx : log1pf(expf(xx));
            sm[t8] = sigmoidf_(BA[h]); sm[4 + t8] = expf(-expf(p->in[17][h]) * sp); }
    }
    __syncthreads();
#pragma unroll
    for (int gg = 0; gg < 2; ++gg) { const int g = wv + 4 * gg, x = g >> 2, t = g & 3; LAS float* v = qkv + (x * 4 + t) * 128 + 2 * lane;
      const float v0 = v[0], v1 = v[1]; const float sc = rsqrtf(wave_sum(v0 * v0 + v1 * v1) + 1e-6f) * (x == 0 ? 0.08838834764831845f : 1.f);
      v[0] = v0 * sc; v[1] = v1 * sc; }
    __syncthreads();
#pragma unroll
    for (int t = 0; t < 4; ++t) {
        const LAS float* kt = qkv + (4 + t) * 128 + 64 * dg; const LAS float* qt = qkv + t * 128 + 64 * dg;
        float ks = 0.f;
#pragma unroll
        for (int i4 = 0; i4 < 16; ++i4) { const f32x4 k4 = *(const LAS f32x4*)(kt + 4 * i4);
#pragma unroll
            for (int e = 0; e < 4; ++e) ks += k4[e] * S[4 * i4 + e]; }
        redK[(t * 2 + dg) * 128 + dv] = ks;
        __syncthreads();
        const float kS = redK[(t * 2 + 0) * 128 + dv] + redK[(t * 2 + 1) * 128 + dv];
        const float beta = sm[t], a = sm[4 + t];
        const float vv = beta * (qkv[(8 + t) * 128 + dv] - a * kS);
        float os = 0.f;
#pragma unroll
        for (int i4 = 0; i4 < 16; ++i4) { const f32x4 k4 = *(const LAS f32x4*)(kt + 4 * i4), q4 = *(const LAS f32x4*)(qt + 4 * i4);
#pragma unroll
            for (int e = 0; e < 4; ++e) { const int i = 4 * i4 + e; S[i] = a * S[i] + k4[e] * vv; os += q4[e] * S[i]; } }
        redO[(t * 2 + dg) * 128 + dv] = os;
    }
    float* so = p->out + O_DSS + ((size_t)(b * 8 + h) * 128 + 64 * dg) * 128 + dv;
#pragma unroll
    for (int i = 0; i < 64; ++i) __builtin_nontemporal_store(S[i], so + i * 128);
    __syncthreads();
    { const int t = wv, d = 2 * lane;
        const float o0 = redO[(t * 2 + 0) * 128 + d] + redO[(t * 2 + 1) * 128 + d], o1 = redO[(t * 2 + 0) * 128 + d + 1] + redO[(t * 2 + 1) * 128 + d + 1];
        const float sc = rsqrtf(wave_sum(o0 * o0 + o1 * o1) * (1.f / 128.f) + 1e-6f);
        const size_t row = (size_t)(MP + 4 * b + t);
        const unsigned zz = *(const unsigned*)(PROJ + row * PW + P_Z + 128 * h + 2 * lane);
        const f32x2 gd = *(const f32x2*)(p->in[19] + 2 * lane);
        *(unsigned*)((bf16_t*)(p->ws + WS_OD) + row * 1024 + 128 * h + 2 * lane) = cvt_pk_bf16(o0 * sc * gd[0] * siluf_(bflo(zz)), o1 * sc * gd[1] * siluf_(bfhi(zz))); }
}

__device__ __forceinline__ void pattn_item(KP p, LAS unsigned char* lds, int item) {
    const int tid = ltid();
    const int lane = tid & 63, w = __builtin_amdgcn_readfirstlane(tid >> 6), q = lane >> 4, c = lane & 15;
    const int b = item >> 6, h = (item >> 4) & 3, qt = item & 15;
    const bf16_t* PROJ = (const bf16_t*)(p->ws + WS_PROJ); const bf16_t* MKB = (const bf16_t*)(p->ws + WS_MKB); const bf16_t* MVB = (const bf16_t*)(p->ws + WS_MVB);
    bf16_t* XO = (bf16_t*)(p->ws + WS_XO);
    const size_t Rq = (size_t)b * 2048 + 128 * qt + 16 * w + c;
    u32x4 st[16];
#pragma unroll
    for (int k = 0; k < 16; ++k) { const int id = tid + 512 * k; st[k] = *(const u32x4*)(MKB + (size_t)(b * 256 + (id >> 5)) * 1024 + 256 * h + 8 * (id & 31)); }
    bf16x8 qf[8];
#pragma unroll
    for (int s = 0; s < 8; ++s) qf[s] = *(const bf16x8*)(PROJ + Rq * PW + P_XQ + 256 * h + 32 * s + 8 * q);
    __syncthreads();
#pragma unroll
    for (int k = 0; k < 16; ++k) { const int id = tid + 512 * k; *(LAS u32x4*)(lds + (id >> 5) * 528 + (id & 31) * 16) = st[k]; }
#pragma unroll
    for (int k = 0; k < 16; ++k) st[k] = *(const u32x4*)(MVB + (size_t)(b * 256 + 64 * (k & 3) + lane) * 1024 + 256 * h + 8 * (8 * (k >> 2) + w));
    __syncthreads();
    f32x4 acc[16];
#pragma unroll
    for (int kt = 0; kt < 16; ++kt) { f32x4 a = (f32x4){0.f, 0.f, 0.f, 0.f};
#pragma unroll
        for (int s = 0; s < 8; ++s) a = MFMA16(*(const LAS bf16x8*)(lds + (16 * kt + c) * 528 + (32 * s + 8 * q) * 2), qf[s], a);
        acc[kt] = a * 0.0625f; }
    __syncthreads();
#pragma unroll
    for (int k = 0; k < 16; ++k) { const int key = 64 * (k & 3) + lane, d0 = 8 * (8 * (k >> 2) + w), pos = (key & ~31) + perm_pos(key & 31);
        LAS bf16_t* dst = (LAS bf16_t*)lds + d0 * 264 + pos;
        dst[0 * 264] = (bf16_t)(st[k].x & 0xffffu); dst[1 * 264] = (bf16_t)(st[k].x >> 16); dst[2 * 264] = (bf16_t)(st[k].y & 0xffffu); dst[3 * 264] = (bf16_t)(st[k].y >> 16);
        dst[4 * 264] = (bf16_t)(st[k].z & 0xffffu); dst[5 * 264] = (bf16_t)(st[k].z >> 16); dst[6 * 264] = (bf16_t)(st[k].w & 0xffffu); dst[7 * 264] = (bf16_t)(st[k].w >> 16); }
    float m = -3.0e38f;
#pragma unroll
    for (int kt = 0; kt < 16; ++kt) m = fmaxf(m, fmaxf(fmaxf(acc[kt][0], acc[kt][1]), fmaxf(acc[kt][2], acc[kt][3])));
    m = fmaxf(m, __shfl_xor(m, 16)); m = fmaxf(m, __shfl_xor(m, 32));
    float sum = 0.f;
#pragma unroll
    for (int kt = 0; kt < 16; ++kt) {
#pragma unroll
        for (int r = 0; r < 4; ++r) { acc[kt][r] = __expf(acc[kt][r] - m); sum += acc[kt][r]; } }
    sum += __shfl_xor(sum, 16); sum += __shfl_xor(sum, 32);
    const float inv = 1.f / sum;
    bf16x8 Pb[8];
#pragma unroll
    for (int s = 0; s < 8; ++s) Pb[s] = pack8(acc[2 * s] * inv, acc[2 * s + 1] * inv);
    __syncthreads();
#pragma unroll 4
    for (int dt = 0; dt < 16; ++dt) { f32x4 o = (f32x4){0.f, 0.f, 0.f, 0.f};
#pragma unroll
        for (int s = 0; s < 8; ++s) o = MFMA16(*(const LAS bf16x8*)(lds + (16 * dt + c) * 528 + (32 * s + 8 * q) * 2), Pb[s], o);
        u32x2 wv; wv.x = cvt_pk_bf16(o[0], o[1]); wv.y = cvt_pk_bf16(o[2], o[3]);
        *(u32x2*)(XO + Rq * 1024 + 256 * h + 16 * dt + 4 * q) = wv; }
}

template <int NS>
__device__ __forceinline__ void load_row(KP p, int row, int lane, f32x4 (&v)[8]) {
    if (row < MP) { const bf16_t* src = (const bf16_t*)(p->ws + WS_D2) + (size_t)row * 2048 + 8 * lane;
#pragma unroll
        for (int j = 0; j < 4; ++j) { const u32x4 w = *(const u32x4*)(src + 512 * j);
            v[2 * j] = (f32x4){bflo(w.x), bfhi(w.x), bflo(w.y), bfhi(w.y)}; v[2 * j + 1] = (f32x4){bflo(w.z), bfhi(w.z), bflo(w.w), bfhi(w.w)}; }
    } else { const float* sl = (const float*)(p->ws + WS_SL) + (size_t)(row - MP) * 2048 + 8 * lane;
#pragma unroll
        for (int j2 = 0; j2 < 8; ++j2) v[j2] = *(const f32x4*)(sl + 512 * (j2 >> 1) + 4 * (j2 & 1));
#pragma unroll 1
        for (int k = 1; k < NS; ++k) {
#pragma unroll
            for (int j2 = 0; j2 < 8; ++j2) v[j2] += *(const f32x4*)(sl + k * SLAB_ELEMS + 512 * (j2 >> 1) + 4 * (j2 & 1)); } }
}
__device__ __forceinline__ void rowpass1(KP p) {
    const int tid = ltid(), lane = tid & 63, wave = tid >> 6;
    const int gw = blockIdx.x * 8 + wave, NGW = gridDim.x * 8;
    bf16_t* F = (bf16_t*)(p->ws + WS_CB);
    f32x4 vn[8]; if (gw < MT) load_row<8>(p, gw, lane, vn);
    for (int row = gw; row < MT; row += NGW) {
        const float* xr = (row < MP ? p->in[0] + (size_t)row * 2048 : p->in[1] + (size_t)(row - MP) * 2048) + 8 * lane;
        float* yo = p->out + O_Y + (size_t)row * 2048 + 8 * lane;
        f32x4 v[8];
#pragma unroll
        for (int j = 0; j < 8; ++j) v[j] = vn[j];
        if (row + NGW < MT) load_row<8>(p, row + NGW, lane, vn);
        float ss = 0.f;
#pragma unroll
        for (int j = 0; j < 8; ++j) ss += (v[j][0] * v[j][0] + v[j][1] * v[j][1]) + (v[j][2] * v[j][2] + v[j][3] * v[j][3]);
        const float sc = rsqrtf(wave_sum(ss) * (1.f / 2048.f) + 1e-6f);
        float s2 = 0.f;
#pragma unroll
        for (int j = 0; j < 8; ++j) { const int co = 512 * (j >> 1) + 4 * (j & 1);
            const f32x4 g = *(const f32x4*)(p->in[25] + 8 * lane + co), xx = *(const f32x4*)(xr + co);
            v[j] = xx + v[j] * sc * g; *(f32x4*)(yo + co) = v[j];
            s2 += (v[j][0] * v[j][0] + v[j][1] * v[j][1]) + (v[j][2] * v[j][2] + v[j][3] * v[j][3]); }
        const float sc2 = rsqrtf(wave_sum(s2) * (1.f / 2048.f) + 1e-6f);
#pragma unroll
        for (int j = 0; j < 4; ++j) { const f32x4 g0 = *(const f32x4*)(p->in[26] + 8 * lane + 512 * j), g1 = *(const f32x4*)(p->in[26] + 8 * lane + 512 * j + 4);
            const f32x4 a = v[2 * j] * sc2 * g0, c = v[2 * j + 1] * sc2 * g1;
            u32x4 w; w.x = cvt_pk_bf16(a[0], a[1]); w.y = cvt_pk_bf16(a[2], a[3]); w.z = cvt_pk_bf16(c[0], c[1]); w.w = cvt_pk_bf16(c[2], c[3]);
            *(u32x4*)(F + (size_t)row * 2048 + 8 * lane + 512 * j) = w; }
    }
}
__device__ __forceinline__ void rowpass2(KP p) {
    const int tid = ltid(), lane = tid & 63, wave = tid >> 6;
    const int gw = blockIdx.x * 8 + wave, NGW = gridDim.x * 8;
    f32x4 vn[8]; if (gw < MT) load_row<11>(p, gw, lane, vn);
    for (int row = gw; row < MT; row += NGW) {
        float* yo = p->out + O_Y + (size_t)row * 2048 + 8 * lane;
        f32x4 v[8];
#pragma unroll
        for (int j = 0; j < 8; ++j) v[j] = vn[j];
        if (row + NGW < MT) load_row<11>(p, row + NGW, lane, vn);
        float ss = 0.f;
#pragma unroll
        for (int j = 0; j < 8; ++j) ss += (v[j][0] * v[j][0] + v[j][1] * v[j][1]) + (v[j][2] * v[j][2] + v[j][3] * v[j][3]);
        const float sc = rsqrtf(wave_sum(ss) * (1.f / 2048.f) + 1e-6f);
#pragma unroll
        for (int j = 0; j < 8; ++j) { const int co = 512 * (j >> 1) + 4 * (j & 1);
            const f32x4 g = *(const f32x4*)(p->in[30] + 8 * lane + co), hh = *(const f32x4*)(yo + co);
            __builtin_nontemporal_store(hh + v[j] * sc * g, (f32x4*)(yo + co)); }
    }
}

#define XB_TMO      128
#define XB_XCNT(j)  (256  + 64 * (j))
#define XB_XSUB(j)  (1280 + 64 * (j))
#define XB_XGEN(j)  (2304 + 64 * (j))
#define XB_TOP      3328
#define XB_TOPGEN   3392
#define XCD_BAR_WORDS 3456
#define XB_SPIN_CAP (1u << 18)

__device__ __forceinline__ unsigned xb_ld(unsigned* p)              { return __hip_atomic_load(p, __ATOMIC_RELAXED, __HIP_MEMORY_SCOPE_AGENT); }
__device__ __forceinline__ unsigned xb_add(unsigned* p, unsigned v) { return __hip_atomic_fetch_add(p, v, __ATOMIC_RELAXED, __HIP_MEMORY_SCOPE_AGENT); }
__device__ __forceinline__ unsigned xb_xcc_id() { return (unsigned)__builtin_amdgcn_s_getreg((3 << 11) | 20) & 0xFu; }
#define XB_SPIN(cond, bar) do { unsigned _sp = 0; while (cond) { __builtin_amdgcn_s_sleep(1); \
    if ((++_sp & 255u) == 0u) { if (xb_ld(&(bar)[XB_TMO])) break; if (_sp > XB_SPIN_CAP) { atomicAdd(&(bar)[XB_TMO], 1u); break; } } } } while (0)

struct XcdBarrier {
    unsigned* bar; unsigned x;
    volatile LAS unsigned* st;
};

__device__ __forceinline__ XcdBarrier xcd_barrier_post(unsigned* bar, volatile LAS unsigned* st) {
    XcdBarrier b; b.bar = bar; b.x = xb_xcc_id(); b.st = st;
    if (threadIdx.x == 0) (void)xb_add(&bar[XB_XCNT(b.x)], 1u);
    return b;
}
__device__ __forceinline__ void xcd_barrier_complete(unsigned* bar, unsigned x, unsigned& nloc, unsigned& nx) {
    const unsigned G = gridDim.x * gridDim.y * gridDim.z;
    unsigned sum, cnt, mine, sp = 0u;
    for (;;) {
        sum = 0u; cnt = 0u; mine = 0u;
#pragma unroll
        for (unsigned j = 0; j < 16; ++j) { const unsigned c = xb_ld(&bar[XB_XCNT(j)]); sum += c; cnt += (c > 0u) ? 1u : 0u; mine = (j == x) ? c : mine; }
        if (sum == G) break;
        __builtin_amdgcn_s_sleep(1);
        if ((++sp & 255u) == 0u) { if (xb_ld(&bar[XB_TMO])) break; if (sp > XB_SPIN_CAP) { atomicAdd(&bar[XB_TMO], 1u); break; } }
    }
    nloc = mine > 0u ? mine : 1u; nx = cnt > 0u ? cnt : 1u;
}

__device__ __forceinline__ void xcd_barrier(const XcdBarrier& b) {
    asm volatile("s_waitcnt vmcnt(0)" ::: "memory");
    __syncthreads();
    if (threadIdx.x == 0) {
        unsigned* bar = b.bar;
        __builtin_amdgcn_s_waitcnt(0);
        unsigned nloc = b.st[0], nx = b.st[1];
        if (nloc == 0u) { xcd_barrier_complete(bar, b.x, nloc, nx); b.st[0] = nloc; b.st[1] = nx; }
        const unsigned old = xb_add(&bar[XB_XSUB(b.x)], 1u);
        const unsigned gen = old / nloc;
        if (old + 1u == (gen + 1u) * nloc) {
            __builtin_amdgcn_fence(__ATOMIC_RELEASE, "agent");
            asm volatile("s_waitcnt vmcnt(0)" ::: "memory");
            const unsigned og = xb_add(&bar[XB_TOP], 1u);
            const unsigned tg = og / nx;
            if (og + 1u == (tg + 1u) * nx) xb_add(&bar[XB_TOPGEN], 1u);
            else XB_SPIN(xb_ld(&bar[XB_TOPGEN]) == tg, bar);
            __builtin_amdgcn_fence(__ATOMIC_ACQUIRE, "agent");
            xb_add(&bar[XB_XGEN(b.x)], 1u);
            asm volatile("s_waitcnt vmcnt(0)" ::: "memory");
        } else {
            XB_SPIN(xb_ld(&bar[XB_XGEN(b.x)]) == gen, bar);
            __builtin_amdgcn_fence(__ATOMIC_ACQUIRE, "agent");
            asm volatile("s_waitcnt vmcnt(0)" ::: "memory");
        }
    }
    __syncthreads();
}

__global__ void __launch_bounds__(512, 2) mega_fwd(Params p_unused) {
#define p kparams()
    extern __shared__ __attribute__((aligned(16))) unsigned char lds_raw[];
    LAS unsigned char* lds = (LAS unsigned char*)lds_raw;
    cg::grid_group grid = cg::this_grid();
    const int lo = p->ph_lo, hi = p->ph_hi, G = gridDim.x, bx = blockIdx.x;
    unsigned char* ws = p->ws;
#ifndef PH_MASK
#define PH_MASK 0x3ff
#endif
#define IN(k) ((((PH_MASK) >> (k)) & 1) && lo <= (k) && (k) < hi)
#define REP(k) _Pragma("unroll 1") for (int rep_ = 0; rep_ <= ((p->dup >> (k)) & 1); ++rep_)
#define SEAM(k) do { if (IN(k) && IN((k) + 1)) _Pragma("unroll 1") for (int sr_ = 0; sr_ <= ((p->dup >> 20) & 1); ++sr_) { xcd_barrier(bar); } } while (0)
    for (int u = ltid(); u < 64; u += 512) ((LAS unsigned*)(lds + 147200))[u] = 0u;
    __syncthreads();
    XcdBarrier bar = xcd_barrier_post((unsigned*)(ws + WS_BAR), (volatile LAS unsigned*)(lds + 147200));
    if (hi > 1000) grid.sync();
    if (IN(0)) REP(0) { __syncthreads(); phase0(p, lds); }
    SEAM(0);
    if (IN(1)) REP(1) {
        Sched1 S{(const bf16_t*)(ws + WS_U), (const bf16_t*)(ws + WS_WT_IN), (const bf16_t*)(ws + WS_MEMN), (const bf16_t*)(ws + WS_WT_MKV), G, bx};
        Epi1 E{(bf16_t*)(ws + WS_PROJ), (float*)(ws + WS_MS), (rep_ == 1 && ((p->dup >> 21) & 1)) ? 1 : 0};
        pg8::gemm_phase<Epi1, Sched1, true, true>(lds, 2048, S, E);
        thin_ba(p);
    }
    SEAM(1);
    if (IN(2)) REP(2) {
#ifndef P2_MASK
#define P2_MASK 31
#endif
#define REPI(k) _Pragma("unroll 1") for (int repi_ = 0; repi_ <= ((p->dup >> (k)) & 1); ++repi_)
        if (P2_MASK & 1) REPI(10) for (int it = bx; it < 1024; it += G) d2_item(p, lds, it);
        if (P2_MASK & 2) REPI(11) for (int it = bx; it < 256; it += G) conv_item<32, false>(p, lds, it);
        if (P2_MASK & 4) REPI(12) for (int it = bx; it < 128; it += G) conv_item<4, true>(p, lds, it);
        if (P2_MASK & 8) REPI(13) for (int it = bx; it < 512; it += G) sattn_item(p, lds, it);
    }
    SEAM(2);
    if (IN(3)) REP(3) {
#ifndef P3_MASK
#define P3_MASK 7
#endif
        if (bx < 32) { if (P3_MASK & 1) REPI(14) scan_item(p, lds, bx); }
        else {
            const int j = bx - 32, nb = G - 32;
            if (P3_MASK & 2) REPI(15) for (int it = j; it < 256; it += nb) pattn_item(p, lds, it);
            if (nb == 224) { const int n0 = j < 32 ? 2 : 5, s0 = j < 32 ? 2 * j : 64 + 5 * (j - 32);
                if (P3_MASK & 4) REPI(16) for (int it = 0; it < n0; it += 2) sdelta_pair(p, lds, s0 + it, s0 + (it + 1 < n0 ? it + 1 : it)); }
            else { if (P3_MASK & 4) REPI(16) for (int it = j; it < 1024; it += nb) sdelta_pair(p, lds, it, it); }
        }
        xcd_barrier(bar);
        REPI(17) for (int it = bx * 8 + (ltid() >> 6); it < 2048; it += G * 8) o_wave_item(p, __builtin_amdgcn_readfirstlane(it));
    }
    SEAM(3);
    if (IN(4)) REP(4) {
        Sched4 S{(const bf16_t*)(ws + WS_CB), (const bf16_t*)(ws + WS_WT_PC), G, bx};
        Epi4 E{(const bf16_t*)(ws + WS_PROJ), (bf16_t*)(ws + WS_U), p->in[15], (float*)(ws + WS_SL)};
        pg8::gemm_phase<Epi4, Sched4, true, true>(lds, 1024, S, E);
        xcd_barrier(bar);
        {
            const float* SL = (const float*)(ws + WS_SL); bf16_t* MG = (bf16_t*)(ws + WS_U) + (size_t)MP * 2048;
            for (int idx = bx * 512 + ltid(); idx < (int)(SLAB_ELEMS / 8); idx += G * 512) {
                f32x4 a0 = *(const f32x4*)(SL + (size_t)idx * 8), a1 = *(const f32x4*)(SL + (size_t)idx * 8 + 4);
#pragma unroll
                for (int sl = 1; sl < 12; ++sl) { a0 += *(const f32x4*)(SL + sl * SLAB_ELEMS + (size_t)idx * 8); a1 += *(const f32x4*)(SL + sl * SLAB_ELEMS + (size_t)idx * 8 + 4); }
                u32x4 w; w.x = cvt_pk_bf16(a0[0], a0[1]); w.y = cvt_pk_bf16(a0[2], a0[3]); w.z = cvt_pk_bf16(a1[0], a1[1]); w.w = cvt_pk_bf16(a1[2], a1[3]);
                *(u32x4*)(MG + (size_t)idx * 8) = w; }
        }
    }
    SEAM(4);
    if (IN(5)) REP(5) {
        SchedT S{(const bf16_t*)(ws + WS_U), (const bf16_t*)(ws + WS_WT_O), 2048, 8, G, bx};
        EpiF32S E{(bf16_t*)(ws + WS_D2), (float*)(ws + WS_SL)};
        pg8::gemm_phase<EpiF32S, SchedT, true, true>(lds, 2048, S, E);
    }
    SEAM(5);
    if (IN(6)) REP(6) rowpass1(p);
    SEAM(6);
    if (IN(7)) REP(7) {
        SchedG S{(const bf16_t*)(ws + WS_CB), (const bf16_t*)(ws + WS_WT_GU), 34, 44, 2048, G, bx};
        Epi7 E{(bf16_t*)(ws + WS_PROJ)};
        pg8::gemm_phase<Epi7, SchedG, true, true>(lds, 2048, S, E);
    }
    SEAM(7);
    if (IN(8)) REP(8) {
        SchedT S{(const bf16_t*)(ws + WS_PROJ), (const bf16_t*)(ws + WS_WT_DN), DFF, 11, G, bx};
        EpiF32S E{(bf16_t*)(ws + WS_D2), (float*)(ws + WS_SL)};
        pg8::gemm_phase<EpiF32S, SchedT, true, true>(lds, DFF, S, E);
    }
    SEAM(8);
    if (IN(9)) rowpass2(p);
#ifdef MK_DBG
#ifndef MK_DBG_ROWS
#define MK_DBG_ROWS 0
#endif
    { asm volatile("s_waitcnt vmcnt(0) lgkmcnt(0)" ::: "memory"); __syncthreads(); grid.sync();
      if (threadIdx.x < 64) { __builtin_amdgcn_fence(__ATOMIC_ACQUIRE, "agent"); asm volatile("s_waitcnt vmcnt(0)" ::: "memory"); } __syncthreads();
      const bf16_t* s0 = (const bf16_t*)(ws + (MK_DBG == 1 ? WS_CB : (MK_DBG == 2 ? WS_XO : WS_U)));
      const bf16_t* s1 = (const bf16_t*)(ws + (MK_DBG == 1 ? WS_OD : (MK_DBG == 2 ? WS_XO : WS_U)));
      for (size_t i = (size_t)bx * 512 + threadIdx.x; i < (size_t)MT * 2048; i += (size_t)G * 512) { const size_t row = i >> 11; const int col = (int)(i & 2047);
          float v; if (MK_DBG == 3) v = bf2f(s0[row * 2048 + col]); else v = col < 1024 ? bf2f(s0[row * 1024 + col]) : bf2f(s1[row * 1024 + col - 1024]);
          if (MK_DBG == 2 && (MK_DBG_ROWS == 1 ? row >= MP : row < MP)) v = 0.f;
          p->out[O_Y + i] = v; } }
#endif
#undef IN
#undef SEAM
#undef p
}

#ifndef MK_N_LAUNCHES
#define MK_N_LAUNCHES 1
#endif
extern "C" void kernel_launch(void* const* d_in, const int* in_sizes, int n_in, void* d_out, int out_size, void* d_ws, size_t ws_size, hipStream_t stream) {
    static int grid = 0;
    if (grid == 0) {
        if (n_in != 31 || ws_size < WS_END) { fprintf(stderr, "kernel_launch: unexpected inputs (n_in %d, ws %zu, need %zu)\n", n_in, ws_size, (size_t)WS_END); grid = -1; return; }
        int dev = 0, cus = 0, per_cu = 0;
        (void)hipGetDevice(&dev); (void)hipDeviceGetAttribute(&cus, hipDeviceAttributeMultiprocessorCount, dev);
        if (hipFuncSetAttribute((const void*)mega_fwd, hipFuncAttributeMaxDynamicSharedMemorySize, LDS_BYTES) != hipSuccess) { fprintf(stderr, "kernel_launch: hipFuncSetAttribute failed\n"); grid = -1; return; }
        (void)hipOccupancyMaxActiveBlocksPerMultiprocessor(&per_cu, (const void*)mega_fwd, 512, LDS_BYTES);
        (void)hipGetLastError();
        if (per_cu < 1) { fprintf(stderr, "kernel_launch: occupancy query says %d blocks per CU\n", per_cu); per_cu = 1; }
        grid = cus;
    }
    if (grid < 0) return;
    (void)hipMemsetAsync((char*)d_ws + WS_BAR, 0, XCD_BAR_WORDS * 4, stream);
    Params a{};
    for (int i = 0; i < 31; ++i) a.in[i] = (const float*)d_in[i];
    a.out = (float*)d_out; a.ws = (unsigned char*)d_ws;
#if MK_N_LAUNCHES == 1
#ifndef MK_PH_HI
#define MK_PH_HI 10
#endif
#ifndef DUP_MASK
#define DUP_MASK 0
#endif
    a.ph_lo = 0; a.ph_hi = MK_PH_HI; a.dup = DUP_MASK;
    if (MK_PH_HI < 10) (void)hipMemsetAsync(d_out, 0, (size_t)out_size * 4, stream);
    void* args[] = {&a};
    hipError_t e = hipLaunchCooperativeKernel((const void*)mega_fwd, dim3(grid), dim3(512), args, LDS_BYTES, stream);
    if (e != hipSuccess) fprintf(stderr, "cooperative launch failed: %s (grid %d)\n", hipGetErrorString(e), grid);
#else
    for (int ph = 0; ph < 10; ++ph) { a.ph_lo = ph; a.ph_hi = ph + 1; hipLaunchKernelGGL(mega_fwd, dim3(grid), dim3(512), LDS_BYTES, stream, a); }
#endif
}
```

```cpp
#include <hip/hip_runtime.h>
#include <hip/hip_cooperative_groups.h>
#include <cstdio>
#include <cstdint>
namespace cg = cooperative_groups;

#define LAS __attribute__((address_space(3)))
typedef unsigned short bf16_t;
typedef short bf16x8 __attribute__((ext_vector_type(8)));
typedef float f32x4 __attribute__((ext_vector_type(4)));
typedef float f32x2 __attribute__((ext_vector_type(2)));
typedef unsigned u32x4 __attribute__((ext_vector_type(4)));
typedef unsigned u32x2 __attribute__((ext_vector_type(2)));

constexpr int DM = 2048, MT = 8704, MP = 8192, PW = 12288;
constexpr int P_GLU = 0, P_Q = 1024, P_Z = 4096, P_XQ = 5120, P_G = 6144;
constexpr int WIN_N = 13328, DFF = 5632;
constexpr size_t O_Y = 0, O_MK = 17825792, O_MV = 18874368, O_CP = 19922944, O_DCP = 20045824, O_DSP = 20082688, O_CS = 20606976, O_DCS = 24539136, O_DSS = 25718784;
constexpr size_t WS_WT_IN = 0;
constexpr size_t WS_WT_BA = WS_WT_IN + (size_t)13312 * 2048 * 2;
constexpr size_t WS_WT_PC = WS_WT_BA + 65536;
constexpr size_t WS_WT_PD = WS_WT_PC + 4194304;
constexpr size_t WS_WT_PM = WS_WT_PD + 4194304;
constexpr size_t WS_WT_O = WS_WT_PM + 4194304;
constexpr size_t WS_WT_MKV = WS_WT_O + 8388608;
constexpr size_t WS_WT_GU = WS_WT_MKV + 8388608;
constexpr size_t WS_WT_DN = WS_WT_GU + (size_t)11264 * 2048 * 2;
constexpr size_t WS_U = WS_WT_DN + (size_t)2048 * 5632 * 2;
constexpr size_t WS_MEMN = WS_U + (size_t)MT * 2048 * 2;
constexpr size_t WS_PROJ = WS_MEMN + 4194304;
constexpr size_t WS_BA = WS_PROJ + (size_t)MT * PW * 2;
constexpr size_t WS_MKB = WS_BA + (size_t)MT * 16 * 4;
constexpr size_t WS_MVB = WS_MKB + 2097152;
constexpr size_t WS_MVT = WS_MVB + 2097152;
constexpr size_t WS_CB = WS_MVT + 2097152;
constexpr size_t WS_OD = WS_CB + (size_t)MT * 1024 * 2;
constexpr size_t WS_XO = WS_OD + (size_t)MT * 1024 * 2;
constexpr size_t WS_D2 = WS_XO + (size_t)MT * 1024 * 2;
constexpr size_t D2_BYTES = 90112;
constexpr size_t WS_GL = WS_D2 + (size_t)1024 * D2_BYTES;
constexpr size_t WS_BAR = WS_GL + 4096;
constexpr size_t WS_SL = WS_BAR + 16384;
constexpr size_t SLAB_ELEMS = (size_t)512 * 2048;
constexpr size_t WS_SW = WS_SL + 12 * SLAB_ELEMS * 4;
constexpr size_t WS_END = WS_SW + (size_t)1024 * 8 * 6144;
constexpr size_t WS_MS = WS_SL;
constexpr size_t MS_ELEMS = (size_t)1024 * 2048;
static_assert(WS_MS + 8 * MS_ELEMS * 4 <= WS_END, "mem_kv slabs must fit the SL | SW regions");
constexpr int LDS_BYTES = 147456;

struct Params { const float* in[31]; float* out; unsigned char* ws; int ph_lo, ph_hi, dup, pad; };
typedef const __attribute__((address_space(4))) Params* KP;
__device__ __forceinline__ KP kparams() { KP k = (KP)__builtin_amdgcn_kernarg_segment_ptr(); asm volatile("" : "+s"(k)); return k; }

typedef __bf16 v2bf_t __attribute__((ext_vector_type(2)));
__device__ __forceinline__ unsigned cvt_pk_bf16(float lo, float hi) { const f32x2 f = {lo, hi}; const v2bf_t r = __builtin_convertvector(f, v2bf_t); return __builtin_bit_cast(unsigned, r); }
__device__ __forceinline__ float bflo(unsigned w) { return __uint_as_float(w << 16); }
__device__ __forceinline__ float bfhi(unsigned w) { return __uint_as_float(w & 0xffff0000u); }
__device__ __forceinline__ float bf2f(bf16_t b) { return __uint_as_float(((unsigned)b) << 16); }
__device__ __forceinline__ bf16_t f2bf(float f) { return (bf16_t)(cvt_pk_bf16(f, 0.f) & 0xffffu); }
__device__ __forceinline__ float sigmoidf_(float x) { return __builtin_amdgcn_rcpf(1.f + __expf(-x)); }
__device__ __forceinline__ float siluf_(float x) { return x * sigmoidf_(x); }
__device__ __forceinline__ float wave_sum(float v) {
#pragma unroll
    for (int o = 1; o < 64; o <<= 1) v += __shfl_xor(v, o);
    return v;
}
__device__ __forceinline__ float wave_max(float v) {
#pragma unroll
    for (int o = 1; o < 64; o <<= 1) v = fmaxf(v, __shfl_xor(v, o));
    return v;
}
__device__ __forceinline__ bf16x8 pack8(f32x4 a, f32x4 b) {
    u32x4 w; w.x = cvt_pk_bf16(a[0], a[1]); w.y = cvt_pk_bf16(a[2], a[3]); w.z = cvt_pk_bf16(b[0], b[1]); w.w = cvt_pk_bf16(b[2], b[3]);
    return __builtin_bit_cast(bf16x8, w);
}
__device__ __forceinline__ int ltid() { int t = threadIdx.x; asm volatile("" : "+v"(t)); return t; }
#define LDS_WAIT() asm volatile("s_waitcnt lgkmcnt(0)" ::: "memory")
#define MFMA16(a, b, c) __builtin_amdgcn_mfma_f32_16x16x32_bf16((a), (b), (c), 0, 0, 0)
__device__ __forceinline__ int perm_off(int p) { return 16 * ((p & 7) >> 2) + 4 * (p >> 3) + (p & 3); }
__device__ __forceinline__ int perm_pos(int o) { return (((o >> 2) & 3) << 3) | ((o >> 4) << 2) | (o & 3); }

namespace pg8 {
#define PG8_LAS __attribute__((address_space(3)))
constexpr int BM = 256, BK = 64, HALF = 128, HTB = HALF * BK * 2, STAGE_BYTES = 8 * HTB, NXCD = 8, WGM = 8;
__host__ __device__ __forceinline__ int lds_byte(int r, int c) { const int st = (r >> 4) * 2 + (c >> 5), rr = r & 15, cc = c & 31, ob = rr * 64 + cc * 2; return st * 1024 + (ob ^ (((ob >> 9) & 1) << 5)); }
__host__ __device__ __forceinline__ void stage_rc(int b, int& R, int& C) { const int st = b / 1024, sb = b % 1024, swz = sb ^ (((sb >> 9) & 1) << 5); R = (st >> 1) * 16 + swz / 64; C = (st & 1) * 32 + (swz % 64) / 2; }
__host__ __device__ __forceinline__ int perm32(int rho) { const int n = rho >> 4, i = rho & 15; return 8 * (i >> 2) + 4 * n + (i & 3); }
struct Unit { int pm, pn, br, ks; };
__device__ __forceinline__ void map_unit(int L, int nM, int nN, int& pm, int& pn) {
    const int nwg = nM * nN; int wgid = L;
    { const int q = nwg / NXCD, r = nwg % NXCD, xcd = wgid % NXCD, off = wgid / NXCD; wgid = (xcd < r ? xcd * (q + 1) : r * (q + 1) + (xcd - r) * q) + off; }
    const int nig = WGM * nN, gid = wgid / nig, fm = gid * WGM, gsz = (nM - fm) < WGM ? (nM - fm) : WGM;
    pm = fm + ((wgid % nig) % gsz); pn = (wgid % nig) / gsz;
}
template <class Epi, class Sched, bool ALIGN_EPI = false, bool SP2 = false>
__device__ __forceinline__ void gemm_phase(PG8_LAS unsigned char* lds, const int K_, const Sched& S, const Epi& E) {
    const int tid = ltid(), wid = __builtin_amdgcn_readfirstlane(tid >> 6), lane = tid & 63, wr = wid >> 2, wc = wid & 3, fr = lane & 15, fq = lane >> 4;
    const int K = K_; int nt = K / BK;
    unsigned voffA[2], voffB[2];
#pragma unroll
    for (int i = 0; i < 2; ++i) { int R, C; stage_rc(tid * 16 + i * 8192, R, C); const int Rb = Epi::PERM ? ((R & ~31) + perm32(R & 31)) : R;
        voffA[i] = (unsigned)(R * K + C) * 2u; voffB[i] = (unsigned)(Rb * K + C) * 2u; }
    const size_t kstep = (size_t)(BK * 2);
    const size_t hstep = (size_t)HALF * K * 2;
    const size_t tstep = 2 * hstep;
    const unsigned ldsw = (unsigned)wid * 1024u;
    const int aoff = lds_byte(wr * 64 + fr, fq * 8), boff = lds_byte(wc * 32 + fr, fq * 8);
#define PG8_SA(b, h) (((b) * 2 + (h)) * HTB)
#define PG8_SB(b, h) ((4 + (b) * 2 + (h)) * HTB)
#define PG8_STAGE(bufoff, gbase, voff) do { _Pragma("unroll") for (int _i = 0; _i < 2; ++_i) \
        __builtin_amdgcn_global_load_lds((const unsigned*)((const char*)(gbase) + (voff)[_i]), (PG8_LAS unsigned*)(lds + (bufoff) + ldsw + _i * 8192), 16, 0, 0); } while (0)
#define PG8_LDA(dst, b, h) do { _Pragma("unroll") for (int m = 0; m < 4; ++m) _Pragma("unroll") for (int k = 0; k < 2; ++k) dst[m][k] = *(const PG8_LAS bf16x8*)(lds + PG8_SA(b, h) + aoff + m * 2048 + k * 1024); } while (0)
#define PG8_LDB(dst, b, h) do { _Pragma("unroll") for (int n = 0; n < 2; ++n) _Pragma("unroll") for (int k = 0; k < 2; ++k) dst[n][k] = *(const PG8_LAS bf16x8*)(lds + PG8_SB(b, h) + boff + n * 2048 + k * 1024); } while (0)
#define PG8_MMA(ai, bj, At, Bt) do { __builtin_amdgcn_s_setprio(1); _Pragma("unroll") for (int m = 0; m < 4; ++m) _Pragma("unroll") for (int n = 0; n < 2; ++n) _Pragma("unroll") for (int k = 0; k < 2; ++k) \
        acc[ai][bj][m][n] = __builtin_amdgcn_mfma_f32_16x16x32_bf16(Bt[n][k], At[m][k], acc[ai][bj][m][n], 0, 0, 0); __builtin_amdgcn_s_setprio(0); } while (0)
#define PG8_WAIT_V(n) asm volatile("s_waitcnt vmcnt(" #n ")" ::: "memory")
#define PG8_WAIT_L(n) asm volatile("s_waitcnt lgkmcnt(" #n ")" ::: "memory")
#define PG8_BAR __builtin_amdgcn_s_barrier()
#define PG8_SCHED __builtin_amdgcn_sched_barrier(0)
    Unit cur, nxt; int ui = 0;
    if (!S.next(0, cur)) return;
    nt = S.nkt(cur);
    f32x4 acc[2][2][4][2];
#pragma unroll
    for (int a = 0; a < 2; ++a)
#pragma unroll
        for (int b = 0; b < 2; ++b)
#pragma unroll
            for (int m = 0; m < 4; ++m)
#pragma unroll
                for (int n = 0; n < 2; ++n) acc[a][b][m][n] = (f32x4){0.f, 0.f, 0.f, 0.f};
    bf16x8 At[4][2], B0[2][2], B1[2][2];
    const char* cA = S.aptr(cur); const char* cB = S.bptr(cur);
    S.a_ready(cur);
    if constexpr (SP2) {
        PG8_STAGE(PG8_SB(0, 0), cB, voffB); PG8_STAGE(PG8_SB(0, 1), cB + hstep, voffB); PG8_STAGE(PG8_SA(0, 0), cA, voffA); PG8_STAGE(PG8_SA(0, 1), cA + hstep, voffA);
        if (wr == 1) PG8_BAR;
        PG8_WAIT_V(2); PG8_BAR;
        PG8_STAGE(PG8_SB(1, 0), cB + kstep, voffB); PG8_STAGE(PG8_SA(1, 0), cA + kstep, voffA); PG8_STAGE(PG8_SB(1, 1), cB + hstep + kstep, voffB);
        PG8_WAIT_V(6); PG8_BAR;
    } else {
        PG8_STAGE(PG8_SB(0, 0), cB, voffB); PG8_STAGE(PG8_SA(0, 0), cA, voffA); PG8_STAGE(PG8_SB(0, 1), cB + hstep, voffB); PG8_STAGE(PG8_SA(0, 1), cA + hstep, voffA);
        if (wr == 1) PG8_BAR;
        PG8_WAIT_V(4); PG8_BAR;
        PG8_STAGE(PG8_SB(1, 0), cB + kstep, voffB); PG8_STAGE(PG8_SA(1, 0), cA + kstep, voffA); PG8_STAGE(PG8_SB(1, 1), cB + hstep + kstep, voffB);
        PG8_WAIT_V(6); PG8_BAR;
    }
    for (;;) {
        const bool has_next = S.next(ui + 1, nxt);
        const char* nA = has_next ? S.aptr(nxt) : cA; const char* nB = has_next ? S.bptr(nxt) : cB;
        for (int t = 0; t < nt; t += 2) {
            const bool last = (t == nt - 2);
            const char* a1 = cA + (size_t)(t + 1) * kstep;
            const char* a2 = last ? nA : cA + (size_t)(t + 2) * kstep; const char* b2 = last ? nB : cB + (size_t)(t + 2) * kstep;
            const char* a3 = a2 + kstep; const char* b3 = b2 + kstep;
            if (last && has_next) S.a_ready(nxt);
            if constexpr (SP2) {
            PG8_LDB(B0, 0, 0); PG8_LDB(B1, 0, 1); PG8_SCHED; PG8_LDA(At, 0, 0); PG8_STAGE(PG8_SA(1, 1), a1 + hstep, voffA);
            PG8_WAIT_V(8); PG8_WAIT_L(0); PG8_BAR; PG8_MMA(0, 0, At, B0); PG8_MMA(0, 1, At, B1); PG8_BAR; PG8_SCHED;
            PG8_LDA(At, 0, 1); PG8_STAGE(PG8_SB(0, 0), b2, voffB); PG8_STAGE(PG8_SB(0, 1), b2 + hstep, voffB); PG8_STAGE(PG8_SA(0, 0), a2, voffA);
            PG8_WAIT_V(8); PG8_WAIT_L(0); PG8_BAR; PG8_MMA(1, 0, At, B0); PG8_MMA(1, 1, At, B1); PG8_BAR; PG8_SCHED;
            PG8_LDB(B0, 1, 0); PG8_LDB(B1, 1, 1); PG8_SCHED; PG8_LDA(At, 1, 0); PG8_STAGE(PG8_SA(0, 1), a2 + hstep, voffA);
            PG8_WAIT_V(8); PG8_WAIT_L(0); PG8_BAR; PG8_MMA(0, 0, At, B0); PG8_MMA(0, 1, At, B1); PG8_BAR; PG8_SCHED;
            PG8_LDA(At, 1, 1); PG8_STAGE(PG8_SB(1, 0), b3, voffB); PG8_STAGE(PG8_SB(1, 1), b3 + hstep, voffB); PG8_STAGE(PG8_SA(1, 0), a3, voffA);
            PG8_WAIT_V(8); PG8_WAIT_L(0); PG8_BAR; PG8_MMA(1, 0, At, B0); PG8_MMA(1, 1, At, B1); PG8_BAR; PG8_SCHED;
            } else {
            PG8_LDB(B0, 0, 0); PG8_SCHED; PG8_LDA(At, 0, 0); PG8_STAGE(PG8_SA(1, 1), a1 + hstep, voffA);
            PG8_WAIT_L(8); PG8_BAR; PG8_WAIT_L(0); PG8_MMA(0, 0, At, B0); PG8_BAR; PG8_SCHED;
            PG8_LDB(B1, 0, 1); PG8_STAGE(PG8_SB(0, 0), b2, voffB);
            PG8_BAR; PG8_WAIT_L(0); PG8_MMA(0, 1, At, B1); PG8_BAR;
            PG8_LDA(At, 0, 1); PG8_STAGE(PG8_SA(0, 0), a2, voffA);
            PG8_BAR; PG8_WAIT_L(0); PG8_MMA(1, 0, At, B0); PG8_BAR; PG8_SCHED;
            PG8_STAGE(PG8_SB(0, 1), b2 + hstep, voffB);
            PG8_WAIT_V(6); PG8_BAR; PG8_MMA(1, 1, At, B1); PG8_BAR;
            PG8_LDB(B0, 1, 0); PG8_SCHED; PG8_LDA(At, 1, 0); PG8_STAGE(PG8_SA(0, 1), a2 + hstep, voffA);
            PG8_WAIT_L(8); PG8_BAR; PG8_WAIT_L(0); PG8_MMA(0, 0, At, B0); PG8_BAR; PG8_SCHED;
            PG8_LDB(B1, 1, 1); PG8_STAGE(PG8_SB(1, 0), b3, voffB);
            PG8_BAR; PG8_WAIT_L(0); PG8_MMA(0, 1, At, B1); PG8_BAR;
            PG8_LDA(At, 1, 1); PG8_STAGE(PG8_SA(1, 0), a3, voffA);
            PG8_BAR; PG8_WAIT_L(0); PG8_MMA(1, 0, At, B0); PG8_BAR; PG8_SCHED;
            PG8_STAGE(PG8_SB(1, 1), b3 + hstep, voffB);
            PG8_WAIT_V(6); PG8_BAR; PG8_MMA(1, 1, At, B1); PG8_BAR;
            }
        }
        if constexpr (ALIGN_EPI) { if (wr == 0) PG8_BAR; }
        if constexpr (!Epi::AFTER_DRAIN) { E(acc, cur, wr, wc, fr, fq); S.done(cur); }
        if (!has_next) break;
#pragma unroll
        for (int a = 0; a < 2; ++a)
#pragma unroll
            for (int b = 0; b < 2; ++b)
#pragma unroll
                for (int m = 0; m < 4; ++m)
#pragma unroll
                    for (int n = 0; n < 2; ++n) acc[a][b][m][n] = (f32x4){0.f, 0.f, 0.f, 0.f};
        cur = nxt; cA = nA; cB = nB; ++ui; nt = S.nkt(cur);
        if constexpr (ALIGN_EPI) { if (wr == 1) PG8_BAR; }
    }
    PG8_WAIT_V(0);
    if constexpr (!ALIGN_EPI) { if (wr == 0) PG8_BAR; }
    PG8_BAR;
    if constexpr (Epi::AFTER_DRAIN) { E.fused(acc, cur, wr, wc, fr, fq, lds, wid, lane); S.done(cur); }
#undef PG8_SA
#undef PG8_SB
#undef PG8_STAGE
#undef PG8_LDA
#undef PG8_LDB
#undef PG8_MMA
#undef PG8_WAIT_V
#undef PG8_WAIT_L
#undef PG8_BAR
#undef PG8_SCHED
}
}
using pg8::Unit;

struct SchedG {
    const bf16_t* A; const bf16_t* Bt; int nM, nN, K, G, c;
    __device__ __forceinline__ bool next(int i, Unit& u) const { const long L = (long)i * G + c; if (L >= (long)nM * nN) return false; pg8::map_unit((int)L, nM, nN, u.pm, u.pn); u.br = 0; u.ks = -1; return true; }
    __device__ __forceinline__ const char* aptr(const Unit& u) const { return (const char*)(A + (size_t)u.pm * 256 * K); }
    __device__ __forceinline__ const char* bptr(const Unit& u) const { return (const char*)(Bt + (size_t)u.pn * 256 * K); }
    __device__ __forceinline__ int nkt(const Unit&) const { return K / 64; }
    __device__ __forceinline__ void a_ready(const Unit&) const {}
    __device__ __forceinline__ void done(const Unit&) const {}
};
struct Sched1 {
    const bf16_t *U, *WtIn, *MemN, *WtMkv; int G, c;
    __device__ __forceinline__ bool next(int i, Unit& u) const {
        const int nf = c < 1768 ? (1768 - c + G - 1) / G : 0;
        const int jsub = nf * G + c - 1768;
        const bool hassub = jsub < 256, odd = (c & 1) && hassub;
        const int k = odd ? i - 1 : i;
        const bool issub = odd ? (i == 0) : (i == nf);
        if (issub ? !hassub : (k < 0 || k >= nf)) return false;
        const bool full = !issub; const int j = full ? 0 : jsub;
        int pm_, pn_; pg8::map_unit(full ? k * G + c : 0, 34, 52, pm_, pn_);
        const int t = j >> 3;
        u.pm = full ? pm_ : (t >> 3); u.pn = full ? pn_ : (t & 7); u.br = full ? 0 : 1; u.ks = full ? -1 : (j & 7); return true;
    }
    __device__ __forceinline__ const char* aptr(const Unit& u) const { return (const char*)((u.br ? MemN : U) + (size_t)u.pm * 256 * 2048 + (u.br ? u.ks * 256 : 0)); }
    __device__ __forceinline__ const char* bptr(const Unit& u) const { return (const char*)((u.br ? WtMkv : WtIn) + (size_t)u.pn * 256 * 2048 + (u.br ? u.ks * 256 : 0)); }
    __device__ __forceinline__ int nkt(const Unit& u) const { return u.br ? 4 : 32; }
    __device__ __forceinline__ void a_ready(const Unit&) const {}
    __device__ __forceinline__ void done(const Unit&) const {}
};
struct Sched4 {
    const bf16_t *A0, *B0; int G, c;
    __device__ __forceinline__ bool next(int i, Unit& u) const {
        const int nfull = 3 * ((256 - c + G - 1) / G);
        const bool pr = i < nfull; const int tri = pr ? (i / 3) * G + c : 0; const int j = pr ? 0 : (i - nfull) * G + c;
        if (j >= 192) return false;
        int pm_, pn_; pg8::map_unit(tri, 32, 8, pm_, pn_);
        const int t = j / 12, rem = j - t * 12;
        u.pm = pr ? pm_ : 32 + (t >> 3); u.pn = pr ? pn_ : (t & 7); u.br = pr ? i % 3 : rem >> 2; u.ks = pr ? -1 : (rem & 3); return true;
    }
    __device__ __forceinline__ int nkt(const Unit& u) const { return u.ks < 0 ? 16 : 4; }
    __device__ __forceinline__ const char* aptr(const Unit& u) const { return (const char*)(A0 + (size_t)u.br * ((size_t)MT * 1024) + (size_t)u.pm * 256 * 1024 + (u.ks < 0 ? 0 : u.ks * 256)); }
    __device__ __forceinline__ const char* bptr(const Unit& u) const { return (const char*)(B0 + (size_t)u.br * 2097152 + (size_t)u.pn * 256 * 1024 + (u.ks < 0 ? 0 : u.ks * 256)); }
    __device__ __forceinline__ void a_ready(const Unit&) const {}
    __device__ __forceinline__ void done(const Unit&) const {}
};
struct SchedT {
    const bf16_t* A; const bf16_t* Bt; int K, S, G, c;
    __device__ __forceinline__ bool next(int i, Unit& u) const {
        const int L = i * G + c; const bool pr = L < 256; const int j = pr ? 0 : L - 256;
        if (j >= 16 * S) return false;
        int pm_, pn_; pg8::map_unit(pr ? L : 0, 32, 8, pm_, pn_);
        const int t = j / S;
        u.br = 0; u.pm = pr ? pm_ : 32 + (t >> 3); u.pn = pr ? pn_ : (t & 7); u.ks = pr ? -1 : j - t * S; return true;
    }
    __device__ __forceinline__ int nkt(const Unit& u) const { return u.ks < 0 ? K / 64 : (K / 64) / S; }
    __device__ __forceinline__ const char* aptr(const Unit& u) const { return (const char*)(A + (size_t)u.pm * 256 * K + (u.ks < 0 ? 0 : u.ks * ((K / 64) / S) * 64)); }
    __device__ __forceinline__ const char* bptr(const Unit& u) const { return (const char*)(Bt + (size_t)u.pn * 256 * K + (u.ks < 0 ? 0 : u.ks * ((K / 64) / S) * 64)); }
    __device__ __forceinline__ void a_ready(const Unit&) const {}
    __device__ __forceinline__ void done(const Unit&) const {}
};

struct EpiF32 {
    static constexpr bool PERM = false, AFTER_DRAIN = false;
    float* C; int ldc;
    __device__ __forceinline__ void operator()(const f32x4 (&acc)[2][2][4][2], const Unit& u, int wr, int wc, int fr, int fq) const {
        const int row0 = u.pm * 256 + wr * 64 + fr, col0 = u.pn * 256 + wc * 32 + 4 * fq;
#pragma unroll
        for (int ai = 0; ai < 2; ++ai)
#pragma unroll
            for (int m = 0; m < 4; ++m) { float* rowp = C + (size_t)(row0 + ai * 128 + m * 16) * ldc + col0;
#pragma unroll
                for (int bj = 0; bj < 2; ++bj)
#pragma unroll
                    for (int n = 0; n < 2; ++n) *(f32x4*)(rowp + bj * 128 + n * 16) = acc[ai][bj][m][n]; }
    }
};
struct EpiF32S {
    static constexpr bool PERM = true, AFTER_DRAIN = false;
    bf16_t* C; float* SL;
    __device__ __forceinline__ void operator()(const f32x4 (&acc)[2][2][4][2], const Unit& u, int wr, int wc, int fr, int fq) const {
        const int row0 = u.pm * 256 + wr * 64 + fr, col0 = u.pn * 256 + wc * 32 + 8 * fq;
        if (u.ks < 0) {
#pragma unroll
            for (int ai = 0; ai < 2; ++ai)
#pragma unroll
                for (int m = 0; m < 4; ++m)
#pragma unroll
                    for (int bj = 0; bj < 2; ++bj) { const f32x4 v0 = acc[ai][bj][m][0], v1 = acc[ai][bj][m][1];
                        u32x4 w; w.x = cvt_pk_bf16(v0[0], v0[1]); w.y = cvt_pk_bf16(v0[2], v0[3]); w.z = cvt_pk_bf16(v1[0], v1[1]); w.w = cvt_pk_bf16(v1[2], v1[3]);
                        *(u32x4*)(C + (size_t)(row0 + ai * 128 + m * 16) * 2048 + col0 + bj * 128) = w; }
        } else {
            float* base = SL + (size_t)u.ks * SLAB_ELEMS - (size_t)MP * 2048;
#pragma unroll
            for (int ai = 0; ai < 2; ++ai)
#pragma unroll
                for (int m = 0; m < 4; ++m)
#pragma unroll
                    for (int bj = 0; bj < 2; ++bj) { float* o = base + (size_t)(row0 + ai * 128 + m * 16) * 2048 + col0 + bj * 128;
                        *(f32x4*)o = acc[ai][bj][m][0]; *(f32x4*)(o + 4) = acc[ai][bj][m][1]; }
        }
    }
};
struct Epi1 {
    static constexpr bool PERM = true, AFTER_DRAIN = false;
    bf16_t* PROJ; float* MS; int skip;
    __device__ __forceinline__ void operator()(const f32x4 (&acc)[2][2][4][2], const Unit& u, int wr, int wc, int fr, int fq) const {
        if (skip) return;
        const int row0 = u.pm * 256 + wr * 64 + fr;
        if (u.br == 0) {
            if (u.pn < 8) {
                const int col = u.pn * 128 + wc * 32 + 8 * fq;
#pragma unroll
                for (int ai = 0; ai < 2; ++ai)
#pragma unroll
                    for (int m = 0; m < 4; ++m) {
                        f32x4 v0, v1;
#pragma unroll
                        for (int j = 0; j < 4; ++j) { v0[j] = acc[ai][0][m][0][j] * sigmoidf_(acc[ai][1][m][0][j]); v1[j] = acc[ai][0][m][1][j] * sigmoidf_(acc[ai][1][m][1][j]); }
                        u32x4 w; w.x = cvt_pk_bf16(v0[0], v0[1]); w.y = cvt_pk_bf16(v0[2], v0[3]); w.z = cvt_pk_bf16(v1[0], v1[1]); w.w = cvt_pk_bf16(v1[2], v1[3]);
                        __builtin_nontemporal_store(w, (u32x4*)(PROJ + (size_t)(row0 + ai * 128 + m * 16) * PW + col));
                    }
            } else {
                const int col = u.pn * 256 - 1024 + wc * 32 + 8 * fq; const bool sig = u.pn >= 28;
#pragma unroll
                for (int ai = 0; ai < 2; ++ai)
#pragma unroll
                    for (int m = 0; m < 4; ++m)
#pragma unroll
                        for (int bj = 0; bj < 2; ++bj) {
                            f32x4 v0 = acc[ai][bj][m][0], v1 = acc[ai][bj][m][1];
                            if (sig) {
#pragma unroll
                                for (int j = 0; j < 4; ++j) { v0[j] = sigmoidf_(v0[j]); v1[j] = sigmoidf_(v1[j]); } }
                            u32x4 w; w.x = cvt_pk_bf16(v0[0], v0[1]); w.y = cvt_pk_bf16(v0[2], v0[3]); w.z = cvt_pk_bf16(v1[0], v1[1]); w.w = cvt_pk_bf16(v1[2], v1[3]);
                            __builtin_nontemporal_store(w, (u32x4*)(PROJ + (size_t)(row0 + ai * 128 + m * 16) * PW + col + bj * 128));
                        }
            }
        } else {
            const int col = u.pn * 256 + wc * 32 + 8 * fq; float* ms = MS + (size_t)u.ks * MS_ELEMS;
#pragma unroll
            for (int ai = 0; ai < 2; ++ai)
#pragma unroll
                for (int m = 0; m < 4; ++m)
#pragma unroll
                    for (int bj = 0; bj < 2; ++bj) {
                        const size_t o = (size_t)(row0 + ai * 128 + m * 16) * 2048 + col + bj * 128;
                        *(f32x4*)(ms + o) = acc[ai][bj][m][0]; *(f32x4*)(ms + o + 4) = acc[ai][bj][m][1];
                    }
        }
    }
};
struct Epi4 {
    static constexpr bool PERM = true, AFTER_DRAIN = false;
    const bf16_t* PROJ; bf16_t* MERGED; const float* bpc; float* SL;
    __device__ __forceinline__ void operator()(const f32x4 (&acc)[2][2][4][2], const Unit& u, int wr, int wc, int fr, int fq) const {
        const int row0 = u.pm * 256 + wr * 64 + fr, col0 = u.pn * 256 + wc * 32 + 8 * fq;
#pragma unroll
        for (int bj = 0; bj < 2; ++bj) {
            const int col = col0 + bj * 128;
            f32x4 b0 = (f32x4){0.f, 0.f, 0.f, 0.f}, b1 = b0;
            if (u.br == 0 && u.ks <= 0) { b0 = *(const f32x4*)(bpc + col); b1 = *(const f32x4*)(bpc + col + 4); }
#pragma unroll
            for (int ai = 0; ai < 2; ++ai) {
                u32x4 g[4], pr[4];
#pragma unroll
                for (int m = 0; m < 4; ++m) { const size_t row = (size_t)(row0 + ai * 128 + m * 16);
                    g[m] = *(const u32x4*)(PROJ + row * PW + P_G + 2048 * u.br + col);
                    pr[m] = (u32x4){0u, 0u, 0u, 0u};
                    if (u.br != 0 && u.ks < 0) pr[m] = *(const u32x4*)(MERGED + row * 2048 + col); }
#pragma unroll
                for (int m = 0; m < 4; ++m) { const size_t row = (size_t)(row0 + ai * 128 + m * 16);
                    f32x4 v0 = acc[ai][bj][m][0] + b0, v1 = acc[ai][bj][m][1] + b1;
                    v0[0] *= bflo(g[m].x); v0[1] *= bfhi(g[m].x); v0[2] *= bflo(g[m].y); v0[3] *= bfhi(g[m].y);
                    v1[0] *= bflo(g[m].z); v1[1] *= bfhi(g[m].z); v1[2] *= bflo(g[m].w); v1[3] *= bfhi(g[m].w);
                    if (u.ks >= 0) { float* sp = SL + (size_t)(u.br * 4 + u.ks) * SLAB_ELEMS + (row - MP) * 2048 + col;
                        *(f32x4*)sp = v0; *(f32x4*)(sp + 4) = v1; continue; }
                    v0[0] += bflo(pr[m].x); v0[1] += bfhi(pr[m].x); v0[2] += bflo(pr[m].y); v0[3] += bfhi(pr[m].y);
                    v1[0] += bflo(pr[m].z); v1[1] += bfhi(pr[m].z); v1[2] += bflo(pr[m].w); v1[3] += bfhi(pr[m].w);
                    u32x4 w; w.x = cvt_pk_bf16(v0[0], v0[1]); w.y = cvt_pk_bf16(v0[2], v0[3]); w.z = cvt_pk_bf16(v1[0], v1[1]); w.w = cvt_pk_bf16(v1[2], v1[3]);
                    *(u32x4*)(MERGED + row * 2048 + col) = w; }
                asm volatile("" ::: "memory");
            }
        }
    }
};
struct Epi7 {
    static constexpr bool PERM = true, AFTER_DRAIN = false;
    bf16_t* HMID;
    __device__ __forceinline__ void operator()(const f32x4 (&acc)[2][2][4][2], const Unit& u, int wr, int wc, int fr, int fq) const {
        const int row0 = u.pm * 256 + wr * 64 + fr, col = u.pn * 128 + wc * 32 + 8 * fq;
#pragma unroll
        for (int ai = 0; ai < 2; ++ai)
#pragma unroll
            for (int m = 0; m < 4; ++m) {
                f32x4 v0, v1;
#pragma unroll
                for (int j = 0; j < 4; ++j) { v0[j] = siluf_(acc[ai][0][m][0][j]) * acc[ai][1][m][0][j]; v1[j] = siluf_(acc[ai][0][m][1][j]) * acc[ai][1][m][1][j]; }
                u32x4 w; w.x = cvt_pk_bf16(v0[0], v0[1]); w.y = cvt_pk_bf16(v0[2], v0[3]); w.z = cvt_pk_bf16(v1[0], v1[1]); w.w = cvt_pk_bf16(v1[2], v1[3]);
                *(u32x4*)(HMID + (size_t)(row0 + ai * 128 + m * 16) * DFF + col) = w;
            }
    }
};

__device__ __forceinline__ void tr_item(const float* __restrict__ W, int ldw, int srccol0, int k0, bf16_t* WT, int ldt, int dstrow0, LAS float* scr, int lane) {
#pragma unroll 16
    for (int i = 0; i < 64; ++i) scr[i * 65 + lane] = __builtin_nontemporal_load(W + (size_t)(k0 + i) * ldw + srccol0 + lane);
    LDS_WAIT();
    const int c = lane & 7, nn = lane >> 3;
#pragma unroll
    for (int jj = 0; jj < 8; ++jj) { const int n = nn + 8 * jj; const LAS float* s = scr + (8 * c) * 65 + n;
        u32x4 o; o.x = cvt_pk_bf16(s[0], s[65]); o.y = cvt_pk_bf16(s[130], s[195]); o.z = cvt_pk_bf16(s[260], s[325]); o.w = cvt_pk_bf16(s[390], s[455]);
        *(u32x4*)(WT + (size_t)(dstrow0 + n) * ldt + k0 + 8 * c) = o; }
    LDS_WAIT();
}
__device__ __forceinline__ void rms_row_to_bf16(const float* x, const float* g, bf16_t* o, int lane) {
    f32x4 v[8]; float ss = 0.f;
#pragma unroll
    for (int j = 0; j < 8; ++j) { v[j] = __builtin_nontemporal_load((const f32x4*)(x + 4 * lane + 256 * j)); ss += (v[j][0] * v[j][0] + v[j][1] * v[j][1]) + (v[j][2] * v[j][2] + v[j][3] * v[j][3]); }
    const float sc = rsqrtf(wave_sum(ss) * (1.f / 2048.f) + 1e-6f);
#pragma unroll
    for (int j = 0; j < 8; ++j) { const f32x4 gg = *(const f32x4*)(g + 4 * lane + 256 * j);
        u32x2 w; w.x = cvt_pk_bf16(v[j][0] * sc * gg[0], v[j][1] * sc * gg[1]); w.y = cvt_pk_bf16(v[j][2] * sc * gg[2], v[j][3] * sc * gg[3]);
        *(u32x2*)(o + 4 * lane + 256 * j) = w; }
}
__device__ __forceinline__ void phase0(KP p, LAS unsigned char* lds) {
    const int tid = ltid(), lane = tid & 63, wave = tid >> 6;
    const int gw = blockIdx.x * 8 + wave, NGW = gridDim.x * 8;
    LAS float* scr = (LAS float*)(lds + wave * 16640);
    unsigned char* ws = p->ws;
    for (int it = gw; it < 18688; it += NGW) {
        int r = it;
        if (r < 6656) { const int kb = r / 208, nb = r % 208, n0 = 64 * nb; int src;
            if (n0 < 2048) { const int tile = n0 >> 8, within = n0 & 255; src = within < 128 ? 128 * tile + within : 1024 + 128 * tile + (within - 128); }
            else if (n0 < 6144) src = n0; else src = n0 + 16;
            tr_item(p->in[9], WIN_N, src, 64 * kb, (bf16_t*)(ws + WS_WT_IN), 2048, n0, scr, lane); continue; }
        r -= 6656;
        if (r < 5632) { const int kb = r / 176, nb = r % 176, n0 = 64 * nb, tile = n0 >> 8, within = n0 & 255;
            tr_item(within < 128 ? p->in[27] : p->in[28], DFF, 128 * tile + (within & 127), 64 * kb, (bf16_t*)(ws + WS_WT_GU), 2048, n0, scr, lane); continue; }
        r -= 5632;
        if (r < 2816) { const int kb = r >> 5, nb = r & 31; tr_item(p->in[29], 2048, 64 * nb, 64 * kb, (bf16_t*)(ws + WS_WT_DN), DFF, 64 * nb, scr, lane); continue; }
        r -= 2816;
        if (r < 1024) { const int kb = r >> 5, nb = r & 31; tr_item(p->in[24], 2048, 64 * nb, 64 * kb, (bf16_t*)(ws + WS_WT_O), 2048, 64 * nb, scr, lane); continue; }
        r -= 1024;
        if (r < 1024) { const int kb = r >> 5, nb = r & 31; tr_item(p->in[22], 2048, 64 * nb, 64 * kb, (bf16_t*)(ws + WS_WT_MKV), 2048, 64 * nb, scr, lane); continue; }
        r -= 1024;
        { const int which = r >> 9, r2 = r & 511, kb = r2 >> 5, nb = r2 & 31;
          const float* W = which == 0 ? p->in[14] : (which == 1 ? p->in[20] : p->in[23]);
          bf16_t* WT = (bf16_t*)(ws + (which == 0 ? WS_WT_PC : (which == 1 ? WS_WT_PD : WS_WT_PM)));
          tr_item(W, 2048, 64 * nb, 64 * kb, WT, 1024, 64 * nb, scr, lane); }
    }
    { bf16_t* wba = (bf16_t*)(ws + WS_WT_BA); const float* win = p->in[9];
      for (int idx = blockIdx.x * 512 + tid; idx < 32768; idx += gridDim.x * 512) { const int k = idx >> 4, n = idx & 15; wba[n * 2048 + k] = f2bf(win[(size_t)k * WIN_N + 6144 + n]); } }
    for (int row = gw; row < MT + 1024; row += NGW) {
        if (row < MP) rms_row_to_bf16(p->in[0] + (size_t)row * 2048, p->in[8], (bf16_t*)(ws + WS_U) + (size_t)row * 2048, lane);
        else if (row < MT) rms_row_to_bf16(p->in[1] + (size_t)(row - MP) * 2048, p->in[8], (bf16_t*)(ws + WS_U) + (size_t)row * 2048, lane);
        else rms_row_to_bf16(p->in[2] + (size_t)(row - MT) * 2048, p->in[21], (bf16_t*)(ws + WS_MEMN) + (size_t)(row - MT) * 2048, lane);
    }
}

__device__ __forceinline__ void thin_ba(KP p) {
    const int tid = ltid(), lane = tid & 63, wave = tid >> 6, q = lane >> 4, c = lane & 15;
    const int gw = blockIdx.x * 8 + wave, NGW = gridDim.x * 8;
    const bf16_t* U = (const bf16_t*)(p->ws + WS_U); const bf16_t* WB = (const bf16_t*)(p->ws + WS_WT_BA); float* BA = (float*)(p->ws + WS_BA);
    for (int item = gw; item < 544; item += NGW) {
        const int r0 = item * 16; f32x4 acc = (f32x4){0.f, 0.f, 0.f, 0.f};
        const bf16_t* ap = U + (size_t)(r0 + c) * 2048 + 8 * q; const bf16_t* bp = WB + (size_t)c * 2048 + 8 * q;
#pragma unroll 32
        for (int s = 0; s < 64; ++s) { const bf16x8 a = *(const bf16x8*)(ap + 32 * s), b = *(const bf16x8*)(bp + 32 * s); acc = MFMA16(a, b, acc); }
#pragma unroll
        for (int r = 0; r < 4; ++r) BA[(size_t)(r0 + 4 * q + r) * 16 + c] = acc[r];
    }
}

__device__ __forceinline__ void d2_item(KP p, LAS unsigned char* lds, int item) {
    const int tid = ltid();
    const int lane = tid & 63, wave = __builtin_amdgcn_readfirstlane(tid >> 6), q = lane >> 4, cl = lane & 15;
    const int c = item & 31, h = (item >> 5) & 7, b = item >> 8;
    const int R0 = b * 2048 + c * 64;
    LAS float* R = (LAS float*)lds;
    LAS bf16_t* qb = (LAS bf16_t*)(lds + 65536);
    LAS bf16_t* kb = (LAS bf16_t*)(lds + 82944);
    LAS float* Lm = (LAS float*)(lds + 100352);
    LAS float* sm_beta = (LAS float*)(lds + 116736);
    LAS float* sm_gam = sm_beta + 64; LAS float* sm_eg = sm_beta + 128; LAS float* sm_egl = sm_beta + 192;
    LAS float* X = R;
    const bf16_t* PROJ = (const bf16_t*)(p->ws + WS_PROJ);
    unsigned char* d2 = p->ws + WS_D2 + (size_t)item * D2_BYTES;
    bf16_t* KCp = (bf16_t*)d2; bf16_t* QGp = (bf16_t*)(d2 + 16384); bf16_t* KGTp = (bf16_t*)(d2 + 32768); bf16_t* QKdp = (bf16_t*)(d2 + 49152); float* Uc = (float*)(d2 + 57344);
    unsigned rawv[3][11]; f32x2 wv4[3][4];
#pragma unroll
    for (int x = 0; x < 3; ++x) { const int ch = 1024 * x + 128 * h + 2 * lane;
#pragma unroll
        for (int j = 0; j < 4; ++j) wv4[x][j] = *(const f32x2*)(p->in[16] + j * 3072 + ch);
#pragma unroll
        for (int rr = 0; rr < 11; ++rr) { const int ti = 8 * wave + rr - 3; rawv[x][rr] = 0u;
            if (c * 64 + ti >= 0) rawv[x][rr] = __builtin_nontemporal_load((const unsigned*)(PROJ + (size_t)(R0 + ti) * PW + P_Q + ch)); } }
    __syncthreads();
    if (wave == 0) {
        const float* BA = (const float*)(p->ws + WS_BA) + (size_t)(R0 + lane) * 16;
        const float braw = BA[h], araw = BA[8 + h];
        const float beta = sigmoidf_(braw);
        const float xx = araw + p->in[18][h];
        const float sp = xx > 20.f ? xx : log1pf(expf(xx));
        const float g = -expf(p->in[17][h]) * sp;
        float gam = g;
#pragma unroll
        for (int o = 1; o < 64; o <<= 1) { const float t = __shfl_up(gam, o); if (lane >= o) gam += t; }
        const float gl = __shfl(gam, 63);
        sm_beta[lane] = beta; sm_gam[lane] = gam; sm_eg[lane] = expf(gam); sm_egl[lane] = expf(gl - gam);
        if (lane == 63) ((float*)(p->ws + WS_GL))[item] = expf(gam);
    }
    __syncthreads();
    _Pragma("unroll 1") for (int rq_ = 0; rq_ <= ((p->dup >> 22) & 1); ++rq_) {
        const int dp = lane, tg = wave;
#pragma unroll
        for (int x = 0; x < 3; ++x) {
            const int ch = 1024 * x + 128 * h + 2 * dp;
            f32x2 w[4];
#pragma unroll
            for (int j = 0; j < 4; ++j) w[j] = wv4[x][j];
            float r0[11], r1[11];
#pragma unroll
            for (int rr = 0; rr < 11; ++rr) { r0[rr] = bflo(rawv[x][rr]); r1[rr] = bfhi(rawv[x][rr]); }
            if (c == 31 && tg == 7) {
                float* o = p->out + O_DCP + (size_t)b * 3 * 3072 + ch;
#pragma unroll
                for (int k = 0; k < 3; ++k) *(f32x2*)(o + k * 3072) = (f32x2){r0[8 + k], r1[8 + k]};
            }
            float y0[8], y1[8];
#pragma unroll
            for (int ii = 0; ii < 8; ++ii) { float a0 = 0.f, a1 = 0.f;
#pragma unroll
                for (int j = 0; j < 4; ++j) { a0 += w[j][0] * r0[ii + j]; a1 += w[j][1] * r1[ii + j]; }
                y0[ii] = siluf_(a0); y1[ii] = siluf_(a1); }
            if (x < 2) {
#pragma unroll
                for (int ii = 0; ii < 8; ++ii) { const float ss = wave_sum(y0[ii] * y0[ii] + y1[ii] * y1[ii]);
                    const float sc = rsqrtf(ss + 1e-6f) * (x == 0 ? 0.08838834764831845f : 1.f); y0[ii] *= sc; y1[ii] *= sc; }
            }
            if (x == 0) {
                const int dk = 2 * dp, pos = (dk & ~31) + perm_pos(dk & 31);
#pragma unroll
                for (int ii = 0; ii < 8; ++ii) { const int i = 8 * tg + ii; const float e = sm_eg[i];
                    *(LAS unsigned*)(qb + i * 136 + 2 * dp) = cvt_pk_bf16(y0[ii], y1[ii]);
                    *(unsigned*)(QGp + i * 128 + pos) = cvt_pk_bf16(y0[ii] * e, y1[ii] * e); }
            } else if (x == 1) {
                float e[8];
#pragma unroll
                for (int ii = 0; ii < 8; ++ii) { const int i = 8 * tg + ii; e[ii] = sm_egl[i]; const float rs = sm_beta[i] * sm_eg[i];
                    *(LAS f32x2*)(R + i * 256 + 128 + 2 * dp) = (f32x2){y0[ii] * rs, y1[ii] * rs};
                    *(LAS unsigned*)(kb + i * 136 + 2 * dp) = cvt_pk_bf16(y0[ii], y1[ii]); }
                const int s = tg >> 2, pbase = (2 * (tg & 1)) * 8 + ((tg & 3) >> 1) * 4;
                { u32x2 lo, hi;
                  lo.x = cvt_pk_bf16(y0[0] * e[0], y0[1] * e[1]); lo.y = cvt_pk_bf16(y0[2] * e[2], y0[3] * e[3]);
                  hi.x = cvt_pk_bf16(y0[4] * e[4], y0[5] * e[5]); hi.y = cvt_pk_bf16(y0[6] * e[6], y0[7] * e[7]);
                  bf16_t* dst = KGTp + (2 * dp) * 64 + 32 * s + pbase; *(u32x2*)dst = lo; *(u32x2*)(dst + 8) = hi;
                  lo.x = cvt_pk_bf16(y1[0] * e[0], y1[1] * e[1]); lo.y = cvt_pk_bf16(y1[2] * e[2], y1[3] * e[3]);
                  hi.x = cvt_pk_bf16(y1[4] * e[4], y1[5] * e[5]); hi.y = cvt_pk_bf16(y1[6] * e[6], y1[7] * e[7]);
                  dst += 64; *(u32x2*)dst = lo; *(u32x2*)(dst + 8) = hi; }
            } else {
#pragma unroll
                for (int ii = 0; ii < 8; ++ii) { const int i = 8 * tg + ii; const float rs = sm_beta[i]; *(LAS f32x2*)(R + i * 256 + 2 * dp) = (f32x2){y0[ii] * rs, y1[ii] * rs}; }
            }
        }
    }
    __syncthreads();
    _Pragma("unroll 1") for (int rq_ = 0; rq_ <= ((p->dup >> 23) & 1); ++rq_) {
        const int mt = wave >> 1, nt0 = 2 * (wave & 1);
#pragma unroll
        for (int tt = 0; tt < 2; ++tt) {
            const int nt = nt0 + tt;
            f32x4 aK = (f32x4){0.f, 0.f, 0.f, 0.f}, aQ = aK;
            if (nt <= mt) {
#pragma unroll
                for (int s = 0; s < 4; ++s) {
                    const bf16x8 ak = *(const LAS bf16x8*)(kb + (16 * mt + cl) * 136 + 32 * s + 8 * q);
                    const bf16x8 aq = *(const LAS bf16x8*)(qb + (16 * mt + cl) * 136 + 32 * s + 8 * q);
                    const bf16x8 bk = *(const LAS bf16x8*)(kb + (16 * nt + cl) * 136 + 32 * s + 8 * q);
                    aK = MFMA16(ak, bk, aK); aQ = MFMA16(aq, bk, aQ);
                }
            }
            const int j = 16 * nt + cl; const float gj = sm_gam[j];
            const int pj = 32 * (nt >> 1) + ((cl >> 2) << 3) + ((nt & 1) << 2) + (cl & 3);
#pragma unroll
            for (int r = 0; r < 4; ++r) { const int i = 16 * mt + 4 * q + r;
                const float d = (j <= i) ? expf(sm_gam[i] - gj) : 0.f;
                Lm[j * 64 + i] = (j < i) ? aK[r] * sm_beta[i] * d : 0.f;
                QKdp[i * 64 + pj] = f2bf(aQ[r] * d); }
        }
    }
    __syncthreads();
    LAS float* Tt = (LAS float*)(lds + 117760);
    if (tid < 64) {
        const int Bq = tid >> 4, cq = tid & 15;
        float t[16];
#pragma unroll
        for (int i = 0; i < 16; ++i) t[i] = (i == cq) ? 1.f : 0.f;
#pragma unroll
        for (int j = 0; j < 15; ++j) { const LAS float* lc = Lm + (16 * Bq + j) * 64 + 16 * Bq;
#pragma unroll
            for (int i4 = (j + 1) / 4; i4 < 4; ++i4) { const f32x4 l4 = *(const LAS f32x4*)(lc + 4 * i4);
#pragma unroll
                for (int e = 0; e < 4; ++e) if (4 * i4 + e > j) t[4 * i4 + e] -= l4[e] * t[j]; } }
#pragma unroll
        for (int i4 = 0; i4 < 4; ++i4) *(LAS f32x4*)(Tt + Bq * 256 + cq * 16 + 4 * i4) = (f32x4){t[4 * i4], t[4 * i4 + 1], t[4 * i4 + 2], t[4 * i4 + 3]};
    } else if (tid >= 256) {
        const float* MS = (const float*)(p->ws + WS_MS);
        bf16_t* MKB = (bf16_t*)(p->ws + WS_MKB); bf16_t* MVB = (bf16_t*)(p->ws + WS_MVB);
#pragma unroll
        for (int k2 = 0; k2 < 2; ++k2) { const int idx = item * 512 + (tid - 256) + 256 * k2; const int row = idx >> 9, col = (idx & 511) * 4;
            f32x4 a = *(const f32x4*)(MS + (size_t)idx * 4);
#pragma unroll
            for (int k = 1; k < 8; ++k) a += *(const f32x4*)(MS + k * MS_ELEMS + (size_t)idx * 4);
            const bool isv = col >= 1024; const size_t o = (size_t)row * 1024 + (col & 1023);
            *(f32x4*)(p->out + (isv ? O_MV : O_MK) + o) = a;
            u32x2 w; w.x = cvt_pk_bf16(a[0], a[1]); w.y = cvt_pk_bf16(a[2], a[3]);
            *(u32x2*)((isv ? MVB : MKB) + o) = w; }
    }
    __syncthreads();
    {
        const int col0 = 32 * wave + cl;
#pragma unroll 1
        for (int B = 0; B < 4; ++B) {
            LAS float* rb = R + (16 * B + 4 * q) * 256 + col0;
            f32x4 a0, a1;
#pragma unroll
            for (int r = 0; r < 4; ++r) { a0[r] = rb[r * 256]; a1[r] = rb[r * 256 + 16]; }
            const LAS float* lp = Lm + q * 64 + 16 * B + cl; const LAS float* xp = R + q * 256 + col0;
#pragma unroll 4
            for (int s4 = 0; s4 < 4 * B; ++s4) { const float av = -lp[s4 * 256], b0 = xp[s4 * 1024], b1 = xp[s4 * 1024 + 16];
                a0 = __builtin_amdgcn_mfma_f32_16x16x4f32(av, b0, a0, 0, 0, 0); a1 = __builtin_amdgcn_mfma_f32_16x16x4f32(av, b1, a1, 0, 0, 0); }
#pragma unroll
            for (int r = 0; r < 4; ++r) { rb[r * 256] = a0[r]; rb[r * 256 + 16] = a1[r]; }
            LDS_WAIT();
            f32x4 x0 = (f32x4){0.f, 0.f, 0.f, 0.f}, x1 = x0;
            const LAS float* tp = Tt + B * 256 + q * 16 + cl; const LAS float* yp = R + (16 * B + q) * 256 + col0;
#pragma unroll
            for (int s4 = 0; s4 < 4; ++s4) { const float av = tp[s4 * 64], b0 = yp[s4 * 1024], b1 = yp[s4 * 1024 + 16];
                x0 = __builtin_amdgcn_mfma_f32_16x16x4f32(av, b0, x0, 0, 0, 0); x1 = __builtin_amdgcn_mfma_f32_16x16x4f32(av, b1, x1, 0, 0, 0); }
            LDS_WAIT();
#pragma unroll
            for (int r = 0; r < 4; ++r) { rb[r * 256] = x0[r]; rb[r * 256 + 16] = x1[r]; }
            LDS_WAIT();
        }
    }
    __syncthreads();
    _Pragma("unroll 1") for (int rq_ = 0; rq_ <= ((p->dup >> 24) & 1); ++rq_) {
#pragma unroll
    for (int k = 0; k < 2; ++k) { const int id = tid + 512 * k, i = id >> 4, p0 = (id & 15) * 8, s = p0 >> 5, q_ = (p0 & 31) >> 3;
        float v[8];
#pragma unroll
        for (int j = 0; j < 8; ++j) v[j] = X[i * 256 + 128 + 32 * s + 16 * (j >> 2) + 4 * q_ + (j & 3)];
        u32x4 w; w.x = cvt_pk_bf16(v[0], v[1]); w.y = cvt_pk_bf16(v[2], v[3]); w.z = cvt_pk_bf16(v[4], v[5]); w.w = cvt_pk_bf16(v[6], v[7]);
        *(u32x4*)(KCp + i * 128 + p0) = w; }
#pragma unroll
    for (int k = 0; k < 16; ++k) { const int idx = tid + 512 * k, w_ = idx >> 10, mt = (idx >> 8) & 3, r = (idx >> 6) & 3, ln = idx & 63;
        Uc[idx] = X[(16 * mt + 4 * (ln >> 4) + r) * 256 + 16 * w_ + (ln & 15)]; }
    }
}

template <int NT, bool SAMPLE>
__device__ __forceinline__ void conv_item(KP p, LAS unsigned char* lds, int idx) {
    const int tid = ltid();
    const int lane = tid & 63, wave = __builtin_amdgcn_readfirstlane(tid >> 6), ch = 2 * tid;
    const bf16_t* PROJ = (const bf16_t*)(p->ws + WS_PROJ);
    bf16_t* CB = (bf16_t*)(p->ws + WS_CB);
    LAS float* T = (LAS float*)lds;
    const int b = SAMPLE ? idx : (idx >> 6), t0 = SAMPLE ? 0 : (idx & 63) * 32;
    float w0[31], w1[31], P0[31], P1[31];
#pragma unroll
    for (int j = 0; j < 31; ++j) { const f32x2 wv = *(const f32x2*)(p->in[10] + j * 1024 + ch); w0[j] = wv[0]; w1[j] = wv[1]; P0[j] = 0.f; P1[j] = 0.f; }
    const f32x2 bd = *(const f32x2*)(p->in[11] + ch);
    __syncthreads();
#define CONV_STEP(x0_, x1_, r_) do { const float cx0 = (x0_), cx1 = (x1_); const int cr = (r_); \
        const float e0 = fmaf(w0[30], cx0, P0[30]), e1 = fmaf(w1[30], cx1, P1[30]); \
        _Pragma("unroll") for (int j = 30; j >= 1; --j) { P0[j] = fmaf(w0[j - 1], cx0, P0[j - 1]); P1[j] = fmaf(w1[j - 1], cx1, P1[j - 1]); asm volatile("" : "+v"(P0[j]), "+v"(P1[j])); } \
        P0[0] = 0.f; P1[0] = 0.f; \
        if (cr >= 30 && cr < NT + 30) *(LAS f32x2*)(T + (cr - 30) * 1024 + ch) = (f32x2){e0 + bd[0], e1 + bd[1]}; } while (0)
    if (SAMPLE) {
#pragma unroll 1
        for (int rb = 0; rb < 30; rb += 10) {
            f32x2 xr[10];
#pragma unroll
            for (int k = 0; k < 10; ++k) xr[k] = __builtin_nontemporal_load((const f32x2*)(p->in[5] + ((size_t)b * 30 + rb + k) * 1024 + ch));
#pragma unroll
            for (int k = 0; k < 10; ++k) { const int r = rb + k;
                if (r >= 4) *(f32x2*)(p->out + O_CS + ((size_t)b * 30 + (r - 4)) * 1024 + ch) = xr[k];
                CONV_STEP(xr[k][0], xr[k][1], r); }
        }
        unsigned xn[4];
#pragma unroll
        for (int k = 0; k < 4; ++k) xn[k] = *(const unsigned*)(PROJ + (size_t)(MP + 4 * b + k) * PW + P_GLU + ch);
#pragma unroll
        for (int k = 0; k < 4; ++k) { const float x0 = bflo(xn[k]), x1 = bfhi(xn[k]);
            *(f32x2*)(p->out + O_CS + ((size_t)b * 30 + 26 + k) * 1024 + ch) = (f32x2){x0, x1};
            CONV_STEP(x0, x1, 30 + k); }
    } else {
#define CONV_LOAD(X, rb_) do { _Pragma("unroll") for (int k = 0; k < 8; ++k) { const int t = t0 - 30 + (rb_) + k; X[k] = 0u; \
            if (t >= 0 && (rb_) + k < 62) X[k] = __builtin_nontemporal_load((const unsigned*)(PROJ + (size_t)(b * 2048 + t) * PW + P_GLU + ch)); } } while (0)
#define CONV_GROUP(X, rb_) do { _Pragma("unroll") for (int k = 0; k < 8; ++k) { const int r = (rb_) + k, t = t0 - 30 + r; const float x0 = bflo(X[k]), x1 = bfhi(X[k]); \
            if (t >= 2018 && r < 62) *(f32x2*)(p->out + O_CP + ((size_t)b * 30 + (t - 2018)) * 1024 + ch) = (f32x2){x0, x1}; \
            CONV_STEP(x0, x1, r); } } while (0)
        unsigned xa[8], xb[8];
        CONV_LOAD(xa, 0);
#pragma unroll 1
        for (int rb = 0; rb < 64; rb += 16) {
            CONV_LOAD(xb, rb + 8);
            CONV_GROUP(xa, rb);
            if (rb + 16 < 64) CONV_LOAD(xa, rb + 16);
            CONV_GROUP(xb, rb + 8);
        }
#undef CONV_LOAD
#undef CONV_GROUP
    }
#undef CONV_STEP
    __syncthreads();
    for (int tt = wave; tt < NT; tt += 8) {
        f32x4 v[4]; float s1 = 0.f, s2 = 0.f;
#pragma unroll
        for (int k = 0; k < 4; ++k) { v[k] = *(const LAS f32x4*)(T + tt * 1024 + 4 * lane + 256 * k);
            s1 += (v[k][0] + v[k][1]) + (v[k][2] + v[k][3]); s2 += (v[k][0] * v[k][0] + v[k][1] * v[k][1]) + (v[k][2] * v[k][2] + v[k][3] * v[k][3]); }
        s1 = wave_sum(s1); s2 = wave_sum(s2);
        const float mu = s1 * (1.f / 1024.f), var = s2 * (1.f / 1024.f) - mu * mu, rs = rsqrtf(fmaxf(var, 0.f) + 1e-5f);
        const size_t row = SAMPLE ? (size_t)(MP + 4 * b + tt) : (size_t)(b * 2048 + t0 + tt);
#pragma unroll
        for (int k = 0; k < 4; ++k) { const int c4 = 4 * lane + 256 * k;
            const f32x4 lg = *(const f32x4*)(p->in[12] + c4), lb = *(const f32x4*)(p->in[13] + c4);
            f32x4 y = (v[k] - mu) * rs * lg + lb;
            u32x2 wv; wv.x = cvt_pk_bf16(siluf_(y[0]), siluf_(y[1])); wv.y = cvt_pk_bf16(siluf_(y[2]), siluf_(y[3]));
            *(u32x2*)(CB + row * 1024 + c4) = wv; }
    }
}

__device__ __forceinline__ void sattn_item(KP p, LAS unsigned char* lds, int item) {
    const int tid = ltid();
    const int lane = tid & 63, wave = __builtin_amdgcn_readfirstlane(tid >> 6), q = lane >> 4, c = lane & 15;
    const int b = item >> 2, h = item & 3;
    const bf16_t* PROJ = (const bf16_t*)(p->ws + WS_PROJ);
    LAS float* sc = (LAS float*)lds;
    LAS float* part = (LAS float*)(lds + 4096);
    const float* vp = p->in[4] + ((size_t)(b * 256 + 32 * wave) * 4 + h) * 256 + 4 * lane;
    f32x4 vpre[16];
#pragma unroll
    for (int mm = 0; mm < 16; ++mm) vpre[mm] = __builtin_nontemporal_load((const f32x4*)(vp + (size_t)mm * 1024));
    __syncthreads();
    {
        bf16x8 qf[8];
#pragma unroll
        for (int s = 0; s < 8; ++s) { u32x4 v = (u32x4){0u, 0u, 0u, 0u};
            if (c < 4) v = *(const u32x4*)(PROJ + (size_t)(MP + 4 * b + c) * PW + P_XQ + 256 * h + 32 * s + 8 * q);
            qf[s] = __builtin_bit_cast(bf16x8, v); }
#pragma unroll
        for (int tt = 0; tt < 2; ++tt) { const int kt = 2 * wave + tt;
            const float* kp = p->in[3] + ((size_t)(b * 256 + 16 * kt + c) * 4 + h) * 256 + 8 * q;
            f32x4 acc = (f32x4){0.f, 0.f, 0.f, 0.f};
#pragma unroll
            for (int s = 0; s < 8; ++s) { const f32x4 k0 = __builtin_nontemporal_load((const f32x4*)(kp + 32 * s)), k1 = __builtin_nontemporal_load((const f32x4*)(kp + 32 * s + 4)); acc = MFMA16(pack8(k0, k1), qf[s], acc); }
            if (c < 4) {
#pragma unroll
                for (int r = 0; r < 4; ++r) sc[c * 256 + 16 * kt + 4 * q + r] = acc[r] * 0.0625f; }
        }
    }
    __syncthreads();
    if (wave < 4) { f32x4 v = *(const LAS f32x4*)(sc + wave * 256 + 4 * lane);
        const float m = wave_max(fmaxf(fmaxf(v[0], v[1]), fmaxf(v[2], v[3])));
        v[0] = __expf(v[0] - m); v[1] = __expf(v[1] - m); v[2] = __expf(v[2] - m); v[3] = __expf(v[3] - m);
        const float inv = 1.f / wave_sum((v[0] + v[1]) + (v[2] + v[3]));
        *(LAS f32x4*)(sc + wave * 256 + 4 * lane) = v * inv; }
    __syncthreads();
    {
        f32x4 acc[4];
#pragma unroll
        for (int t = 0; t < 4; ++t) acc[t] = (f32x4){0.f, 0.f, 0.f, 0.f};
        f32x4 vlate[16];
#pragma unroll
        for (int mm = 0; mm < 16; ++mm) vlate[mm] = __builtin_nontemporal_load((const f32x4*)(vp + (size_t)(16 + mm) * 1024));
#pragma unroll
        for (int mm = 0; mm < 16; ++mm) {
#pragma unroll
            for (int t = 0; t < 4; ++t) acc[t] += vpre[mm] * sc[t * 256 + 32 * wave + mm]; }
#pragma unroll
        for (int mm = 0; mm < 16; ++mm) {
#pragma unroll
            for (int t = 0; t < 4; ++t) acc[t] += vlate[mm] * sc[t * 256 + 32 * wave + 16 + mm]; }
#pragma unroll
        for (int t = 0; t < 4; ++t) *(LAS f32x4*)(part + (wave * 4 + t) * 256 + 4 * lane) = acc[t];
    }
    __syncthreads();
    { const int t = tid >> 7, d = (tid & 127) * 2; float s0 = 0.f, s1 = 0.f;
#pragma unroll
      for (int w = 0; w < 8; ++w) { const f32x2 v = *(const LAS f32x2*)(part + (w * 4 + t) * 256 + d); s0 += v[0]; s1 += v[1]; }
      *(unsigned*)((bf16_t*)(p->ws + WS_XO) + (size_t)(MP + 4 * b + t) * 1024 + 256 * h + d) = cvt_pk_bf16(s0, s1); }
}

__device__ __forceinline__ void mkv_reduce(KP p, int bx, int G) {
    const int tid = ltid();
    const float* MS = (const float*)(p->ws + WS_MS);
    bf16_t* MKB = (bf16_t*)(p->ws + WS_MKB); bf16_t* MVB = (bf16_t*)(p->ws + WS_MVB);
    for (int idx = bx * 512 + tid; idx < 1024 * 512; idx += G * 512) { const int row = idx >> 9, col = (idx & 511) * 4;
        f32x4 a = *(const f32x4*)(MS + (size_t)idx * 4);
#pragma unroll
        for (int k = 1; k < 8; ++k) a += *(const f32x4*)(MS + k * MS_ELEMS + (size_t)idx * 4);
        const bool isv = col >= 1024; const size_t o = (size_t)row * 1024 + (col & 1023);
        *(f32x4*)(p->out + (isv ? O_MV : O_MK) + o) = a;
        u32x2 w; w.x = cvt_pk_bf16(a[0], a[1]); w.y = cvt_pk_bf16(a[2], a[3]);
        *(u32x2*)((isv ? MVB : MKB) + o) = w; }
}

__device__ __forceinline__ void scan_item(KP p, LAS unsigned char* lds, int bh) {
    const int tid = ltid();
    const int lane = tid & 63, w = __builtin_amdgcn_readfirstlane(tid >> 6), q = lane >> 4, c = lane & 15;
    const float* GL = (const float*)(p->ws + WS_GL) + bh * 32;
    const unsigned char* d2 = p->ws + WS_D2 + (size_t)bh * 32 * D2_BYTES;
    unsigned char* sw = p->ws + WS_SW + ((size_t)bh * 32 * 8 + w) * 6144 + lane * 16;
    constexpr int BUF = 35840, O_KC = 0, O_KGT = 17408;
    f32x4 St[8];
#pragma unroll
    for (int i = 0; i < 8; ++i) St[i] = (f32x4){0.f, 0.f, 0.f, 0.f};
    u32x4 stg[4]; f32x4 u[4];
    __syncthreads();
#define SCAN_LOAD(chunkp) do { _Pragma("unroll") for (int k = 0; k < 2; ++k) { stg[k] = *(const u32x4*)((chunkp) + (size_t)(tid + 512 * k) * 16); stg[2 + k] = *(const u32x4*)((chunkp) + 32768 + (size_t)(tid + 512 * k) * 16); } } while (0)
#define SCAN_WRITE(bufp) do { \
        _Pragma("unroll") for (int k = 0; k < 2; ++k) { const int id = tid + 512 * k; *(LAS u32x4*)((bufp) + O_KC + (id >> 4) * 272 + (id & 15) * 16) = stg[k]; \
            *(LAS u32x4*)((bufp) + O_KGT + (id >> 3) * 144 + (id & 7) * 16) = stg[2 + k]; } } while (0)
#define SCAN_LOADU(dst, chunkp) do { const float* Uc_ = (const float*)((chunkp) + 57344); \
        _Pragma("unroll") for (int mt = 0; mt < 4; ++mt) _Pragma("unroll") for (int r = 0; r < 4; ++r) dst[mt][r] = Uc_[((w * 4 + mt) * 4 + r) * 64 + lane]; } while (0)
    f32x4 un[4]; u32x4 stg2[4];
    SCAN_LOAD(d2); SCAN_LOADU(u, d2);
    SCAN_WRITE(lds);
    SCAN_LOAD(d2 + D2_BYTES); SCAN_LOADU(un, d2 + D2_BYTES);
    const float glv = GL[lane & 31];
    __syncthreads();
#pragma unroll 1
    for (int step = 0; step < 32; ++step) {
        LAS unsigned char* cur = lds + (step & 1) * BUF; LAS unsigned char* nxt = lds + ((step + 1) & 1) * BUF;
        const bool more = step + 1 < 32, more2 = step + 2 < 32;
        const unsigned char* c2 = d2 + (size_t)(step + 2) * D2_BYTES;
        f32x4 u2[4];
        if (more2) {
#pragma unroll
            for (int k = 0; k < 2; ++k) { stg2[k] = *(const u32x4*)(c2 + (size_t)(tid + 512 * k) * 16); stg2[2 + k] = *(const u32x4*)(c2 + 32768 + (size_t)(tid + 512 * k) * 16); }
            SCAN_LOADU(u2, c2); }
        const float gl = __uint_as_float((unsigned)__builtin_amdgcn_readlane((int)__float_as_uint(glv), step));
        unsigned char* swp = sw + (size_t)step * (8 * 6144);
        bf16x8 Sb[4];
#pragma unroll
        for (int s = 0; s < 4; ++s) { Sb[s] = pack8(St[2 * s], St[2 * s + 1]); *(bf16x8*)(swp + s * 1024) = Sb[s]; }
        f32x4 W[4];
#pragma unroll
        for (int mt = 0; mt < 4; ++mt) { f32x4 a = (f32x4){0.f, 0.f, 0.f, 0.f};
#pragma unroll
            for (int s = 0; s < 4; ++s) a = MFMA16(*(const LAS bf16x8*)(cur + O_KC + (16 * mt + c) * 272 + (32 * s + 8 * q) * 2), Sb[s], a);
            W[mt] = u[mt] - a; }
        bf16x8 Wb[2];
#pragma unroll
        for (int s = 0; s < 2; ++s) { Wb[s] = pack8(W[2 * s], W[2 * s + 1]); *(bf16x8*)(swp + 4096 + s * 1024) = Wb[s]; }
#pragma unroll
        for (int i = 0; i < 8; ++i) { f32x4 a = St[i] * gl;
#pragma unroll
            for (int s = 0; s < 2; ++s) a = MFMA16(*(const LAS bf16x8*)(cur + O_KGT + (16 * i + c) * 144 + (32 * s + 8 * q) * 2), Wb[s], a);
            St[i] = a; }
        if (more) SCAN_WRITE(nxt);
        asm volatile("s_waitcnt lgkmcnt(0)" ::: "memory"); __builtin_amdgcn_s_barrier(); asm volatile("" ::: "memory");
#pragma unroll
        for (int mt = 0; mt < 4; ++mt) { u[mt] = un[mt]; if (more2) un[mt] = u2[mt]; }
        if (more2) {
#pragma unroll
            for (int k = 0; k < 4; ++k) stg[k] = stg2[k]; }
    }
#undef SCAN_LOADU
#undef SCAN_LOAD
#undef SCAN_WRITE
    float* so = p->out + O_DSP + (size_t)bh * 16384;
#pragma unroll
    for (int i = 0; i < 8; ++i)
#pragma unroll
        for (int r = 0; r < 4; ++r) so[(16 * i + 4 * q + r) * 128 + 16 * w + c] = St[i][r];
}

__device__ __forceinline__ void o_wave_item(KP p, int witem) {
    const int lane = ltid() & 63, q = lane >> 4, c = lane & 15;
    const int mh = witem & 1, item = witem >> 1, step = item & 31, bh = item >> 5, h = bh & 7, b = bh >> 3;
    const bf16_t* PROJ = (const bf16_t*)(p->ws + WS_PROJ);
    bf16_t* OD = (bf16_t*)(p->ws + WS_OD);
    const unsigned char* d2 = p->ws + WS_D2 + (size_t)item * D2_BYTES;
    const bf16_t* QGp = (const bf16_t*)(d2 + 16384); const bf16_t* QKp = (const bf16_t*)(d2 + 49152);
    const unsigned char* swp = p->ws + WS_SW + (size_t)item * 8 * 6144 + lane * 16;
    const size_t rowb = (size_t)b * 2048 + 64 * step + 32 * mh;
    bf16x8 ag[2][4], ak[2][2];
#pragma unroll
    for (int m = 0; m < 2; ++m) {
#pragma unroll
        for (int s = 0; s < 4; ++s) ag[m][s] = *(const bf16x8*)(QGp + (32 * mh + 16 * m + c) * 128 + 32 * s + 8 * q);
#pragma unroll
        for (int s = 0; s < 2; ++s) ak[m][s] = *(const bf16x8*)(QKp + (32 * mh + 16 * m + c) * 64 + 32 * s + 8 * q); }
    f32x4 O[2][8]; float ss[2][4];
    bf16_t zr[8][2][4];
#pragma unroll
    for (int nt = 0; nt < 8; ++nt)
#pragma unroll
        for (int m = 0; m < 2; ++m)
#pragma unroll
            for (int r = 0; r < 4; ++r) zr[nt][m][r] = PROJ[(rowb + 16 * m + 4 * q + r) * PW + P_Z + 128 * h + 16 * nt + c];
#pragma unroll
    for (int m = 0; m < 2; ++m)
#pragma unroll
        for (int r = 0; r < 4; ++r) ss[m][r] = 0.f;
#pragma unroll
    for (int nt = 0; nt < 8; ++nt) {
        bf16x8 Sb[4], Wb[2];
#pragma unroll
        for (int s = 0; s < 4; ++s) Sb[s] = *(const bf16x8*)(swp + nt * 6144 + s * 1024);
#pragma unroll
        for (int s = 0; s < 2; ++s) Wb[s] = *(const bf16x8*)(swp + nt * 6144 + 4096 + s * 1024);
#pragma unroll
        for (int m = 0; m < 2; ++m) { f32x4 o = (f32x4){0.f, 0.f, 0.f, 0.f};
#pragma unroll
            for (int s = 0; s < 4; ++s) o = MFMA16(ag[m][s], Sb[s], o);
#pragma unroll
            for (int s = 0; s < 2; ++s) o = MFMA16(ak[m][s], Wb[s], o);
            O[m][nt] = o;
#pragma unroll
            for (int r = 0; r < 4; ++r) ss[m][r] += o[r] * o[r]; }
    }
#pragma unroll
    for (int m = 0; m < 2; ++m)
#pragma unroll
        for (int r = 0; r < 4; ++r) { float t = ss[m][r]; t += __shfl_xor(t, 1); t += __shfl_xor(t, 2); t += __shfl_xor(t, 4); t += __shfl_xor(t, 8);
            ss[m][r] = rsqrtf(t * (1.f / 128.f) + 1e-6f); }
#pragma unroll
    for (int nt = 0; nt < 8; ++nt) { const float gdn = p->in[19][16 * nt + c];
#pragma unroll
        for (int m = 0; m < 2; ++m)
#pragma unroll
            for (int r = 0; r < 4; ++r) { const size_t row = rowb + 16 * m + 4 * q + r;
                const float z = bf2f(zr[nt][m][r]);
                OD[row * 1024 + 128 * h + 16 * nt + c] = f2bf(O[m][nt][r] * ss[m][r] * gdn * siluf_(z)); } }
}

__device__ __forceinline__ void sdelta_pair(KP p, LAS unsigned char* lds0, int item0, int item1) {
    const int tid = ltid();
    const int sub = __builtin_amdgcn_readfirstlane(tid >> 8), t8 = tid & 255, lane = tid & 63, wv = __builtin_amdgcn_readfirstlane((tid >> 6) & 3);
    const int item = sub ? item1 : item0;
    const int b = item >> 3, h = item & 7;
    const bf16_t* PROJ = (const bf16_t*)(p->ws + WS_PROJ);
    LAS unsigned char* lds = lds0 + sub * 32768;
    LAS float* qkv = (LAS float*)lds;
    LAS float* redK = (LAS float*)(lds + 8192);
    LAS float* redO = (LAS float*)(lds + 16384);
    LAS float* sm = (LAS float*)(lds + 24576);
    const int dv = t8 & 127, dg = t8 >> 7;
    const float* s0 = p->in[7] + ((size_t)(b * 8 + h) * 128 + 64 * dg) * 128 + dv;
    float S[64];
#pragma unroll
    for (int i = 0; i < 64; ++i) S[i] = __builtin_nontemporal_load(s0 + i * 128);
    __syncthreads();
    {
        float ev[6][4], wv[6][4];
#pragma unroll
        for (int k = 0; k < 6; ++k) { const int idx = t8 + 256 * k, x = idx >> 9, t = (idx >> 7) & 3, d = idx & 127;
            const int ch = 1024 * x + 128 * h + d;
#pragma unroll
            for (int j = 0; j < 4; ++j) { const int er = t + j;
                ev[k][j] = er < 3 ? p->in[6][((size_t)b * 3 + er) * 3072 + ch] : bf2f(PROJ[(size_t)(MP + 4 * b + er - 3) * PW + P_Q + ch]);
                wv[k][j] = p->in[16][j * 3072 + ch]; } }
#pragma unroll
        for (int k = 0; k < 6; ++k) { const int idx = t8 + 256 * k, x = idx >> 9, t = (idx >> 7) & 3, d = idx & 127;
            const int ch = 1024 * x + 128 * h + d;
            float y = 0.f;
#pragma unroll
            for (int j = 0; j < 4; ++j) y += wv[k][j] * ev[k][j];
            qkv[(x * 4 + t) * 128 + d] = siluf_(y);
            if (t == 3) {
#pragma unroll
                for (int kk = 0; kk < 3; ++kk) p->out[O_DCS + ((size_t)b * 3 + kk) * 3072 + ch] = ev[k][1 + kk]; }
        }
        if (t8 < 4) { const float* BA = (const float*)(p->ws + WS_BA) + (size_t)(MP + 4 * b + t8) * 16;
            const float xx = BA[8 + h] + p->in[18][h]; const float sp = xx > 20.f ? xx : log1pf(expf(xx));
            sm[t8] = sigmoidf_(BA[h]); sm[4 + t8] = expf(-expf(p->in[17][h]) * sp); }
    }
    __syncthreads();
#pragma unroll
    for (int gg = 0; gg < 2; ++gg) { const int g = wv + 4 * gg, x = g >> 2, t = g & 3; LAS float* v = qkv + (x * 4 + t) * 128 + 2 * lane;
      const float v0 = v[0], v1 = v[1]; const float sc = rsqrtf(wave_sum(v0 * v0 + v1 * v1) + 1e-6f) * (x == 0 ? 0.08838834764831845f : 1.f);
      v[0] = v0 * sc; v[1] = v1 * sc; }
    __syncthreads();
#pragma unroll
    for (int t = 0; t < 4; ++t) {
        const LAS float* kt = qkv + (4 + t) * 128 + 64 * dg; const LAS float* qt = qkv + t * 128 + 64 * dg;
        float ks = 0.f;
#pragma unroll
        for (int i4 = 0; i4 < 16; ++i4) { const f32x4 k4 = *(const LAS f32x4*)(kt + 4 * i4);
#pragma unroll
            for (int e = 0; e < 4; ++e) ks += k4[e] * S[4 * i4 + e]; }
        redK[(t * 2 + dg) * 128 + dv] = ks;
        __syncthreads();
        const float kS = redK[(t * 2 + 0) * 128 + dv] + redK[(t * 2 + 1) * 128 + dv];
        const float beta = sm[t], a = sm[4 + t];
        const float vv = beta * (qkv[(8 + t) * 128 + dv] - a * kS);
        float os = 0.f;
#pragma unroll
        for (int i4 = 0; i4 < 16; ++i4) { const f32x4 k4 = *(const LAS f32x4*)(kt + 4 * i4), q4 = *(const LAS f32x4*)(qt + 4 * i4);
#pragma unroll
            for (int e = 0; e < 4; ++e) { const int i = 4 * i4 + e; S[i] = a * S[i] + k4[e] * vv; os += q4[e] * S[i]; } }
        redO[(t * 2 + dg) * 128 + dv] = os;
    }
    float* so = p->out + O_DSS + ((size_t)(b * 8 + h) * 128 + 64 * dg) * 128 + dv;
#pragma unroll
    for (int i = 0; i < 64; ++i) __builtin_nontemporal_store(S[i], so + i * 128);
    __syncthreads();
    { const int t = wv, d = 2 * lane;
        const float o0 = redO[(t * 2 + 0) * 128 + d] + redO[(t * 2 + 1) * 128 + d], o1 = redO[(t * 2 + 0) * 128 + d + 1] + redO[(t * 2 + 1) * 128 + d + 1];
        const float sc = rsqrtf(wave_sum(o0 * o0 + o1 * o1) * (1.f / 128.f) + 1e-6f);
        const size_t row = (size_t)(MP + 4 * b + t);
        const unsigned zz = *(const unsigned*)(PROJ + row * PW + P_Z + 128 * h + 2 * lane);
        const f32x2 gd = *(const f32x2*)(p->in[19] + 2 * lane);
        *(unsigned*)((bf16_t*)(p->ws + WS_OD) + row * 1024 + 128 * h + 2 * lane) = cvt_pk_bf16(o0 * sc * gd[0] * siluf_(bflo(zz)), o1 * sc * gd[1] * siluf_(bfhi(zz))); }
}

__device__ __forceinline__ void pattn_item(KP p, LAS unsigned char* lds, int item) {
    const int tid = ltid();
    const int lane = tid & 63, w = __builtin_amdgcn_readfirstlane(tid >> 6), q = lane >> 4, c = lane & 15;
    const int b = item >> 6, h = (item >> 4) & 3, qt = item & 15;
    const bf16_t* PROJ = (const bf16_t*)(p->ws + WS_PROJ); const bf16_t* MKB = (const bf16_t*)(p->ws + WS_MKB); const bf16_t* MVB = (const bf16_t*)(p->ws + WS_MVB);
    bf16_t* XO = (bf16_t*)(p->ws + WS_XO);
    const size_t Rq = (size_t)b * 2048 + 128 * qt + 16 * w + c;
    u32x4 st[16];
#pragma unroll
    for (int k = 0; k < 16; ++k) { const int id = tid + 512 * k; st[k] = *(const u32x4*)(MKB + (size_t)(b * 256 + (id >> 5)) * 1024 + 256 * h + 8 * (id & 31)); }
    bf16x8 qf[8];
#pragma unroll
    for (int s = 0; s < 8; ++s) qf[s] = *(const bf16x8*)(PROJ + Rq * PW + P_XQ + 256 * h + 32 * s + 8 * q);
    __syncthreads();
#pragma unroll
    for (int k = 0; k < 16; ++k) { const int id = tid + 512 * k; *(LAS u32x4*)(lds + (id >> 5) * 528 + (id & 31) * 16) = st[k]; }
#pragma unroll
    for (int k = 0; k < 16; ++k) st[k] = *(const u32x4*)(MVB + (size_t)(b * 256 + 64 * (k & 3) + lane) * 1024 + 256 * h + 8 * (8 * (k >> 2) + w));
    __syncthreads();
    f32x4 acc[16];
#pragma unroll
    for (int kt = 0; kt < 16; ++kt) { f32x4 a = (f32x4){0.f, 0.f, 0.f, 0.f};
#pragma unroll
        for (int s = 0; s < 8; ++s) a = MFMA16(*(const LAS bf16x8*)(lds + (16 * kt + c) * 528 + (32 * s + 8 * q) * 2), qf[s], a);
        acc[kt] = a * 0.0625f; }
    __syncthreads();
#pragma unroll
    for (int k = 0; k < 16; ++k) { const int key = 64 * (k & 3) + lane, d0 = 8 * (8 * (k >> 2) + w), pos = (key & ~31) + perm_pos(key & 31);
        LAS bf16_t* dst = (LAS bf16_t*)lds + d0 * 264 + pos;
        dst[0 * 264] = (bf16_t)(st[k].x & 0xffffu); dst[1 * 264] = (bf16_t)(st[k].x >> 16); dst[2 * 264] = (bf16_t)(st[k].y & 0xffffu); dst[3 * 264] = (bf16_t)(st[k].y >> 16);
        dst[4 * 264] = (bf16_t)(st[k].z & 0xffffu); dst[5 * 264] = (bf16_t)(st[k].z >> 16); dst[6 * 264] = (bf16_t)(st[k].w & 0xffffu); dst[7 * 264] = (bf16_t)(st[k].w >> 16); }
    float m = -3.0e38f;
#pragma unroll
    for (int kt = 0; kt < 16; ++kt) m = fmaxf(m, fmaxf(fmaxf(acc[kt][0], acc[kt][1]), fmaxf(acc[kt][2], acc[kt][3])));
    m = fmaxf(m, __shfl_xor(m, 16)); m = fmaxf(m, __shfl_xor(m, 32));
    float sum = 0.f;
#pragma unroll
    for (int kt = 0; kt < 16; ++kt) {
#pragma unroll
        for (int r = 0; r < 4; ++r) { acc[kt][r] = __expf(acc[kt][r] - m); sum += acc[kt][r]; } }
    sum += __shfl_xor(sum, 16); sum += __shfl_xor(sum, 32);
    const float inv = 1.f / sum;
    bf16x8 Pb[8];
#pragma unroll
    for (int s = 0; s < 8; ++s) Pb[s] = pack8(acc[2 * s] * inv, acc[2 * s + 1] * inv);
    __syncthreads();
#pragma unroll 4
    for (int dt = 0; dt < 16; ++dt) { f32x4 o = (f32x4){0.f, 0.f, 0.f, 0.f};
#pragma unroll
        for (int s = 0; s < 8; ++s) o = MFMA16(*(const LAS bf16x8*)(lds + (16 * dt + c) * 528 + (32 * s + 8 * q) * 2), Pb[s], o);
        u32x2 wv; wv.x = cvt_pk_bf16(o[0], o[1]); wv.y = cvt_pk_bf16(o[2], o[3]);
        *(u32x2*)(XO + Rq * 1024 + 256 * h + 16 * dt + 4 * q) = wv; }
}

template <int NS>
__device__ __forceinline__ void load_row(KP p, int row, int lane, f32x4 (&v)[8]) {
    if (row < MP) { const bf16_t* src = (const bf16_t*)(p->ws + WS_D2) + (size_t)row * 2048 + 8 * lane;
#pragma unroll
        for (int j = 0; j < 4; ++j) { const u32x4 w = *(const u32x4*)(src + 512 * j);
            v[2 * j] = (f32x4){bflo(w.x), bfhi(w.x), bflo(w.y), bfhi(w.y)}; v[2 * j + 1] = (f32x4){bflo(w.z), bfhi(w.z), bflo(w.w), bfhi(w.w)}; }
    } else { const float* sl = (const float*)(p->ws + WS_SL) + (size_t)(row - MP) * 2048 + 8 * lane;
#pragma unroll
        for (int j2 = 0; j2 < 8; ++j2) v[j2] = *(const f32x4*)(sl + 512 * (j2 >> 1) + 4 * (j2 & 1));
#pragma unroll 1
        for (int k = 1; k < NS; ++k) {
#pragma unroll
            for (int j2 = 0; j2 < 8; ++j2) v[j2] += *(const f32x4*)(sl + k * SLAB_ELEMS + 512 * (j2 >> 1) + 4 * (j2 & 1)); } }
}
__device__ __forceinline__ void rowpass1(KP p) {
    const int tid = ltid(), lane = tid & 63, wave = tid >> 6;
    const int gw = blockIdx.x * 8 + wave, NGW = gridDim.x * 8;
    bf16_t* F = (bf16_t*)(p->ws + WS_CB);
    f32x4 vn[8]; if (gw < MT) load_row<8>(p, gw, lane, vn);
    for (int row = gw; row < MT; row += NGW) {
        const float* xr = (row < MP ? p->in[0] + (size_t)row * 2048 : p->in[1] + (size_t)(row - MP) * 2048) + 8 * lane;
        float* yo = p->out + O_Y + (size_t)row * 2048 + 8 * lane;
        f32x4 v[8];
#pragma unroll
        for (int j = 0; j < 8; ++j) v[j] = vn[j];
        if (row + NGW < MT) load_row<8>(p, row + NGW, lane, vn);
        float ss = 0.f;
#pragma unroll
        for (int j = 0; j < 8; ++j) ss += (v[j][0] * v[j][0] + v[j][1] * v[j][1]) + (v[j][2] * v[j][2] + v[j][3] * v[j][3]);
        const float sc = rsqrtf(wave_sum(ss) * (1.f / 2048.f) + 1e-6f);
        float s2 = 0.f;
#pragma unroll
        for (int j = 0; j < 8; ++j) { const int co = 512 * (j >> 1) + 4 * (j & 1);
            const f32x4 g = *(const f32x4*)(p->in[25] + 8 * lane + co), xx = *(const f32x4*)(xr + co);
            v[j] = xx + v[j] * sc * g; *(f32x4*)(yo + co) = v[j];
            s2 += (v[j][0] * v[j][0] + v[j][1] * v[j][1]) + (v[j][2] * v[j][2] + v[j][3] * v[j][3]); }
        const float sc2 = rsqrtf(wave_sum(s2) * (1.f / 2048.f) + 1e-6f);
#pragma unroll
        for (int j = 0; j < 4; ++j) { const f32x4 g0 = *(const f32x4*)(p->in[26] + 8 * lane + 512 * j), g1 = *(const f32x4*)(p->in[26] + 8 * lane + 512 * j + 4);
            const f32x4 a = v[2 * j] * sc2 * g0, c = v[2 * j + 1] * sc2 * g1;
            u32x4 w; w.x = cvt_pk_bf16(a[0], a[1]); w.y = cvt_pk_bf16(a[2], a[3]); w.z = cvt_pk_bf16(c[0], c[1]); w.w = cvt_pk_bf16(c[2], c[3]);
            *(u32x4*)(F + (size_t)row * 2048 + 8 * lane + 512 * j) = w; }
    }
}
__device__ __forceinline__ void rowpass2(KP p) {
    const int tid = ltid(), lane = tid & 63, wave = tid >> 6;
    const int gw = blockIdx.x * 8 + wave, NGW = gridDim.x * 8;
    f32x4 vn[8]; if (gw < MT) load_row<11>(p, gw, lane, vn);
    for (int row = gw; row < MT; row += NGW) {
        float* yo = p->out + O_Y + (size_t)row * 2048 + 8 * lane;
        f32x4 v[8];
#pragma unroll
        for (int j = 0; j < 8; ++j) v[j] = vn[j];
        if (row + NGW < MT) load_row<11>(p, row + NGW, lane, vn);
        float ss = 0.f;
#pragma unroll
        for (int j = 0; j < 8; ++j) ss += (v[j][0] * v[j][0] + v[j][1] * v[j][1]) + (v[j][2] * v[j][2] + v[j][3] * v[j][3]);
        const float sc = rsqrtf(wave_sum(ss) * (1.f / 2048.f) + 1e-6f);
#pragma unroll
        for (int j = 0; j < 8; ++j) { const int co = 512 * (j >> 1) + 4 * (j & 1);
            const f32x4 g = *(const f32x4*)(p->in[30] + 8 * lane + co), hh = *(const f32x4*)(yo + co);
            __builtin_nontemporal_store(hh + v[j] * sc * g, (f32x4*)(yo + co)); }
    }
}

#define XB_TMO      128
#define XB_XCNT(j)  (256  + 64 * (j))
#define XB_XSUB(j)  (1280 + 64 * (j))
#define XB_XGEN(j)  (2304 + 64 * (j))
#define XB_TOP      3328
#define XB_TOPGEN   3392
#define XCD_BAR_WORDS 3456
#define XB_SPIN_CAP (1u << 18)

__device__ __forceinline__ unsigned xb_ld(unsigned* p)              { return __hip_atomic_load(p, __ATOMIC_RELAXED, __HIP_MEMORY_SCOPE_AGENT); }
__device__ __forceinline__ unsigned xb_add(unsigned* p, unsigned v) { return __hip_atomic_fetch_add(p, v, __ATOMIC_RELAXED, __HIP_MEMORY_SCOPE_AGENT); }
__device__ __forceinline__ unsigned xb_xcc_id() { return (unsigned)__builtin_amdgcn_s_getreg((3 << 11) | 20) & 0xFu; }
#define XB_SPIN(cond, bar) do { unsigned _sp = 0; while (cond) { __builtin_amdgcn_s_sleep(1); \
    if ((++_sp & 255u) == 0u) { if (xb_ld(&(bar)[XB_TMO])) break; if (_sp > XB_SPIN_CAP) { atomicAdd(&(bar)[XB_TMO], 1u); break; } } } } while (0)

struct XcdBarrier {
    unsigned* bar; unsigned x;
    volatile LAS unsigned* st;
};

__device__ __forceinline__ XcdBarrier xcd_barrier_post(unsigned* bar, volatile LAS unsigned* st) {
    XcdBarrier b; b.bar = bar; b.x = xb_xcc_id(); b.st = st;
    if (threadIdx.x == 0) (void)xb_add(&bar[XB_XCNT(b.x)], 1u);
    return b;
}
__device__ __forceinline__ void xcd_barrier_complete(unsigned* bar, unsigned x, unsigned& nloc, unsigned& nx) {
    const unsigned G = gridDim.x * gridDim.y * gridDim.z;
    unsigned sum, cnt, mine, sp = 0u;
    for (;;) {
        sum = 0u; cnt = 0u; mine = 0u;
#pragma unroll
        for (unsigned j = 0; j < 16; ++j) { const unsigned c = xb_ld(&bar[XB_XCNT(j)]); sum += c; cnt += (c > 0u) ? 1u : 0u; mine = (j == x) ? c : mine; }
        if (sum == G) break;
        __builtin_amdgcn_s_sleep(1);
        if ((++sp & 255u) == 0u) { if (xb_ld(&bar[XB_TMO])) break; if (sp > XB_SPIN_CAP) { atomicAdd(&bar[XB_TMO], 1u); break; } }
    }
    nloc = mine > 0u ? mine : 1u; nx = cnt > 0u ? cnt : 1u;
}

__device__ __forceinline__ void xcd_barrier(const XcdBarrier& b) {
    asm volatile("s_waitcnt vmcnt(0)" ::: "memory");
    __syncthreads();
    if (threadIdx.x == 0) {
        unsigned* bar = b.bar;
        __builtin_amdgcn_s_waitcnt(0);
        unsigned nloc = b.st[0], nx = b.st[1];
        if (nloc == 0u) { xcd_barrier_complete(bar, b.x, nloc, nx); b.st[0] = nloc; b.st[1] = nx; }
        const unsigned old = xb_add(&bar[XB_XSUB(b.x)], 1u);
        const unsigned gen = old / nloc;
        if (old + 1u == (gen + 1u) * nloc) {
            __builtin_amdgcn_fence(__ATOMIC_RELEASE, "agent");
            asm volatile("s_waitcnt vmcnt(0)" ::: "memory");
            const unsigned og = xb_add(&bar[XB_TOP], 1u);
            const unsigned tg = og / nx;
            if (og + 1u == (tg + 1u) * nx) xb_add(&bar[XB_TOPGEN], 1u);
            else XB_SPIN(xb_ld(&bar[XB_TOPGEN]) == tg, bar);
            __builtin_amdgcn_fence(__ATOMIC_ACQUIRE, "agent");
            xb_add(&bar[XB_XGEN(b.x)], 1u);
            asm volatile("s_waitcnt vmcnt(0)" ::: "memory");
        } else {
            XB_SPIN(xb_ld(&bar[XB_XGEN(b.x)]) == gen, bar);
            __builtin_amdgcn_fence(__ATOMIC_ACQUIRE, "agent");
            asm volatile("s_waitcnt vmcnt(0)" ::: "memory");
        }
    }
    __syncthreads();
}

__global__ void __launch_bounds__(512, 2) mega_fwd(Params p_unused) {
#define p kparams()
    extern __shared__ __attribute__((aligned(16))) unsigned char lds_raw[];
    LAS unsigned char* lds = (LAS unsigned char*)lds_raw;
    cg::grid_group grid = cg::this_grid();
    const int lo = p->ph_lo, hi = p->ph_hi, G = gridDim.x, bx = blockIdx.x;
    unsigned char* ws = p->ws;
#ifndef PH_MASK
#define PH_MASK 0x3ff
#endif
#define IN(k) ((((PH_MASK) >> (k)) & 1) && lo <= (k) && (k) < hi)
#define REP(k) _Pragma("unroll 1") for (int rep_ = 0; rep_ <= ((p->dup >> (k)) & 1); ++rep_)
#define SEAM(k) do { if (IN(k) && IN((k) + 1)) _Pragma("unroll 1") for (int sr_ = 0; sr_ <= ((p->dup >> 20) & 1); ++sr_) { xcd_barrier(bar); } } while (0)
    for (int u = ltid(); u < 64; u += 512) ((LAS unsigned*)(lds + 147200))[u] = 0u;
    __syncthreads();
    XcdBarrier bar = xcd_barrier_post((unsigned*)(ws + WS_BAR), (volatile LAS unsigned*)(lds + 147200));
    if (hi > 1000) grid.sync();
    if (IN(0)) REP(0) { __syncthreads(); phase0(p, lds); }
    SEAM(0);
    if (IN(1)) REP(1) {
        Sched1 S{(const bf16_t*)(ws + WS_U), (const bf16_t*)(ws + WS_WT_IN), (const bf16_t*)(ws + WS_MEMN), (const bf16_t*)(ws + WS_WT_MKV), G, bx};
        Epi1 E{(bf16_t*)(ws + WS_PROJ), (float*)(ws + WS_MS), (rep_ == 1 && ((p->dup >> 21) & 1)) ? 1 : 0};
        pg8::gemm_phase<Epi1, Sched1, true, true>(lds, 2048, S, E);
        thin_ba(p);
    }
    SEAM(1);
    if (IN(2)) REP(2) {
#ifndef P2_MASK
#define P2_MASK 31
#endif
#define REPI(k) _Pragma("unroll 1") for (int repi_ = 0; repi_ <= ((p->dup >> (k)) & 1); ++repi_)
        if (P2_MASK & 1) REPI(10) for (int it = bx; it < 1024; it += G) d2_item(p, lds, it);
        if (P2_MASK & 2) REPI(11) for (int it = bx; it < 256; it += G) conv_item<32, false>(p, lds, it);
        if (P2_MASK & 4) REPI(12) for (int it = bx; it < 128; it += G) conv_item<4, true>(p, lds, it);
        if (P2_MASK & 8) REPI(13) for (int it = bx; it < 512; it += G) sattn_item(p, lds, it);
    }
    SEAM(2);
    if (IN(3)) REP(3) {
#ifndef P3_MASK
#define P3_MASK 7
#endif
        if (bx < 32) { if (P3_MASK & 1) REPI(14) scan_item(p, lds, bx); }
        else {
            const int j = bx - 32, nb = G - 32;
            if (P3_MASK & 2) REPI(15) for (int it = j; it < 256; it += nb) pattn_item(p, lds, it);
            if (nb == 224) { const int n0 = j < 32 ? 2 : 5, s0 = j < 32 ? 2 * j : 64 + 5 * (j - 32);
                if (P3_MASK & 4) REPI(16) for (int it = 0; it < n0; it += 2) sdelta_pair(p, lds, s0 + it, s0 + (it + 1 < n0 ? it + 1 : it)); }
            else { if (P3_MASK & 4) REPI(16) for (int it = j; it < 1024; it += nb) sdelta_pair(p, lds, it, it); }
        }
        xcd_barrier(bar);
        REPI(17) for (int it = bx * 8 + (ltid() >> 6); it < 2048; it += G * 8) o_wave_item(p, __builtin_amdgcn_readfirstlane(it));
    }
    SEAM(3);
    if (IN(4)) REP(4) {
        Sched4 S{(const bf16_t*)(ws + WS_CB), (const bf16_t*)(ws + WS_WT_PC), G, bx};
        Epi4 E{(const bf16_t*)(ws + WS_PROJ), (bf16_t*)(ws + WS_U), p->in[15], (float*)(ws + WS_SL)};
        pg8::gemm_phase<Epi4, Sched4, true, true>(lds, 1024, S, E);
        xcd_barrier(bar);
        {
            const float* SL = (const float*)(ws + WS_SL); bf16_t* MG = (bf16_t*)(ws + WS_U) + (size_t)MP * 2048;
            for (int idx = bx * 512 + ltid(); idx < (int)(SLAB_ELEMS / 8); idx += G * 512) {
                f32x4 a0 = *(const f32x4*)(SL + (size_t)idx * 8), a1 = *(const f32x4*)(SL + (size_t)idx * 8 + 4);
#pragma unroll
                for (int sl = 1; sl < 12; ++sl) { a0 += *(const f32x4*)(SL + sl * SLAB_ELEMS + (size_t)idx * 8); a1 += *(const f32x4*)(SL + sl * SLAB_ELEMS + (size_t)idx * 8 + 4); }
                u32x4 w; w.x = cvt_pk_bf16(a0[0], a0[1]); w.y = cvt_pk_bf16(a0[2], a0[3]); w.z = cvt_pk_bf16(a1[0], a1[1]); w.w = cvt_pk_bf16(a1[2], a1[3]);
                *(u32x4*)(MG + (size_t)idx * 8) = w; }
        }
    }
    SEAM(4);
    if (IN(5)) REP(5) {
        SchedT S{(const bf16_t*)(ws + WS_U), (const bf16_t*)(ws + WS_WT_O), 2048, 8, G, bx};
        EpiF32S E{(bf16_t*)(ws + WS_D2), (float*)(ws + WS_SL)};
        pg8::gemm_phase<EpiF32S, SchedT, true, true>(lds, 2048, S, E);
    }
    SEAM(5);
    if (IN(6)) REP(6) rowpass1(p);
    SEAM(6);
    if (IN(7)) REP(7) {
        SchedG S{(const bf16_t*)(ws + WS_CB), (const bf16_t*)(ws + WS_WT_GU), 34, 44, 2048, G, bx};
        Epi7 E{(bf16_t*)(ws + WS_PROJ)};
        pg8::gemm_phase<Epi7, SchedG, true, true>(lds, 2048, S, E);
    }
    SEAM(7);
    if (IN(8)) REP(8) {
        SchedT S{(const bf16_t*)(ws + WS_PROJ), (const bf16_t*)(ws + WS_WT_DN), DFF, 11, G, bx};
        EpiF32S E{(bf16_t*)(ws + WS_D2), (float*)(ws + WS_SL)};
        pg8::gemm_phase<EpiF32S, SchedT, true, true>(lds, DFF, S, E);
    }
    SEAM(8);
    if (IN(9)) rowpass2(p);
#ifdef MK_DBG
#ifndef MK_DBG_ROWS
#define MK_DBG_ROWS 0
#endif
    { asm volatile("s_waitcnt vmcnt(0) lgkmcnt(0)" ::: "memory"); __syncthreads(); grid.sync();
      if (threadIdx.x < 64) { __builtin_amdgcn_fence(__ATOMIC_ACQUIRE, "agent"); asm volatile("s_waitcnt vmcnt(0)" ::: "memory"); } __syncthreads();
      const bf16_t* s0 = (const bf16_t*)(ws + (MK_DBG == 1 ? WS_CB : (MK_DBG == 2 ? WS_XO : WS_U)));
      const bf16_t* s1 = (const bf16_t*)(ws + (MK_DBG == 1 ? WS_OD : (MK_DBG == 2 ? WS_XO : WS_U)));
      for (size_t i = (size_t)bx * 512 + threadIdx.x; i < (size_t)MT * 2048; i += (size_t)G * 512) { const size_t row = i >> 11; const int col = (int)(i & 2047);
          float v; if (MK_DBG == 3) v = bf2f(s0[row * 2048 + col]); else v = col < 1024 ? bf2f(s0[row * 1024 + col]) : bf2f(s1[row * 1024 + col - 1024]);
          if (MK_DBG == 2 && (MK_DBG_ROWS == 1 ? row >= MP : row < MP)) v = 0.f;
          p->out[O_Y + i] = v; } }
#endif
#undef IN
#undef SEAM
#undef p
}

#ifndef MK_N_LAUNCHES
#define MK_N_LAUNCHES 1
#endif
extern "C" void kernel_launch(void* const* d_in, const int* in_sizes, int n_in, void* d_out, int out_size, void* d_ws, size_t ws_size, hipStream_t stream) {
    static int grid = 0;
    if (grid == 0) {
        if (n_in != 31 || ws_size < WS_END) { fprintf(stderr, "kernel_launch: unexpected inputs (n_in %d, ws %zu, need %zu)\n", n_in, ws_size, (size_t)WS_END); grid = -1; return; }
        int dev = 0, cus = 0, per_cu = 0;
        (void)hipGetDevice(&dev); (void)hipDeviceGetAttribute(&cus, hipDeviceAttributeMultiprocessorCount, dev);
        if (hipFuncSetAttribute((const void*)mega_fwd, hipFuncAttributeMaxDynamicSharedMemorySize, LDS_BYTES) != hipSuccess) { fprintf(stderr, "kernel_launch: hipFuncSetAttribute failed\n"); grid = -1; return; }
        (void)hipOccupancyMaxActiveBlocksPerMultiprocessor(&per_cu, (const void*)mega_fwd, 512, LDS_BYTES);
        (void)hipGetLastError();
        if (per_cu < 1) { fprintf(stderr, "kernel_launch: occupancy query says %d blocks per CU\n", per_cu); per_cu = 1; }
        grid = cus;
    }
    if (grid < 0) return;
    (void)hipMemsetAsync((char*)d_ws + WS_BAR, 0, XCD_BAR_WORDS * 4, stream);
    Params a{};
    for (int i = 0; i < 31; ++i) a.in[i] = (const float*)d_in[i];
    a.out = (float*)d_out; a.ws = (unsigned char*)d_ws;
#if MK_N_LAUNCHES == 1
#ifndef MK_PH_HI
#define MK_PH_HI 10
#endif
#ifndef DUP_MASK
#define DUP_MASK 0
#endif
    a.ph_lo = 0; a.ph_hi = MK_PH_HI; a.dup = DUP_MASK;
    if (MK_PH_HI < 10) (void)hipMemsetAsync(d_out, 0, (size_t)out_size * 4, stream);
    void* args[] = {&a};
    hipError_t e = hipLaunchCooperativeKernel((const void*)mega_fwd, dim3(grid), dim3(512), args, LDS_BYTES, stream);
    if (e != hipSuccess) fprintf(stderr, "cooperative launch failed: %s (grid %d)\n", hipGetErrorString(e), grid);
#else
    for (int ph = 0; ph < 10; ++ph) { a.ph_lo = ph; a.ph_hi = ph + 1; hipLaunchKernelGGL(mega_fwd, dim3(grid), dim3(512), LDS_BYTES, stream, a); }
#endif
}
```
